# Optimizing an MI355X kernel written in HIP

```python
import jax, jax.numpy as jnp
from jax import lax
import numpy as np

D_MODEL = 2048
BATCH = 2
SEQ = 8192
DEPTH = 2

GRID_W = 64
CTX_LEN = 256
D_LRU = 1024
N_LRU_HEADS = 4
LRU_HEAD_DIM = D_LRU // N_LRU_HEADS
RG_C = 8.0
CONV_SHORT = 4
SHORT_PAD_L = 2
SHORT_PAD_R = 1
D_CONV = 1024
CONV_K = 31
D_MIX = D_LRU + D_CONV
D_IN = 2 * D_LRU + 2 * D_CONV
D_FF = 5632
N_MOD = 9
ALPHA = (2 * DEPTH) ** 0.25
BETA = (8 * DEPTH) ** -0.25
ADA_SCALE = 0.5
EPS = 1e-6

kernel_name = 'hybrid_rglru_conformer_dit_block'


def _layernorm(x, g, b):
    xf = x.astype(jnp.float32)
    mu = jnp.mean(xf, axis=-1, keepdims=True)
    var = jnp.mean(jnp.square(xf - mu), axis=-1, keepdims=True)
    y = (xf - mu) * lax.rsqrt(var + EPS) * g.astype(jnp.float32) + b.astype(jnp.float32)
    return y.astype(x.dtype)


def _modulate(s, shift, scale):
    return s * (1 + scale) + shift


def _swiglu(h, w_in, w_out):
    gate, up = jnp.split(h @ w_in, 2, axis=-1)
    return (jax.nn.silu(gate) * up) @ w_out


def _half_ffn(s, shift, scale, gate, w1, w2, g, b):
    return _layernorm(ALPHA * s + 0.5 * gate * _swiglu(_modulate(s, shift, scale), w1, w2), g, b)


def _dwconv(x, w, b, pad_left, pad_right):
    y = lax.conv_general_dilated(
        x, w.astype(x.dtype)[:, None, :], window_strides=(1,),
        padding=[(pad_left, pad_right)], dimension_numbers=('NWC', 'WIO', 'NWC'),
        feature_group_count=x.shape[-1])
    return y + b


def _lin_combine(left, right):
    a1, b1 = left
    a2, b2 = right
    return a1 * a2, a2 * b1 + b2


def _rglru(xc, w_r, b_r, w_i, b_i, lam, h0, reverse):
    bsz, t, c = xc.shape
    xf = xc.astype(jnp.float32)
    xh = xf.reshape(bsz, t, N_LRU_HEADS, LRU_HEAD_DIM)
    r = jax.nn.sigmoid(jnp.einsum('bthi,hij->bthj', xh, w_r.astype(jnp.float32)).reshape(bsz, t, c)
                       + b_r.astype(jnp.float32))
    i = jax.nn.sigmoid(jnp.einsum('bthi,hij->bthj', xh, w_i.astype(jnp.float32)).reshape(bsz, t, c)
                       + b_i.astype(jnp.float32))
    log_a = -RG_C * r * jax.nn.softplus(-lam.astype(jnp.float32))
    a = jnp.exp(log_a)
    b = jnp.sqrt(-jnp.expm1(2.0 * log_a)) * (i * xf)
    if h0 is not None:
        idx = t - 1 if reverse else 0
        b = b.at[:, idx].add(a[:, idx] * h0)
    _, h = lax.associative_scan(_lin_combine, (a, b), axis=1, reverse=reverse)
    return h


def _conv_module(v, gate, w, b, g, bb, n_seg):
    bsz, t, c = v.shape
    u = (v * jax.nn.sigmoid(gate)).reshape(bsz * n_seg, t // n_seg, c)
    u = _dwconv(u, w, b, CONV_K // 2, CONV_K // 2).reshape(bsz, t, c)
    return jax.nn.silu(_layernorm(u, g, bb))


def _mixer(h_lat, h_ctx, rows, w_in, conv4_w, conv4_b, w_rg, b_rg, w_ig, b_ig, lam,
           conv31_w, conv31_b, cln_g, cln_b, w_out, b_out, ctx_out):
    splits = [D_LRU, 2 * D_LRU, 2 * D_LRU + D_CONV]
    xr_l, gr_l, cv_l, cg_l = jnp.split(h_lat @ w_in, splits, axis=-1)
    if ctx_out:
        xr_c, gr_c, cv_c, cg_c = jnp.split(h_ctx @ w_in, splits, axis=-1)
    else:
        xr_c = h_ctx @ w_in[:, :D_LRU]
    xr_l = _dwconv(xr_l, conv4_w, conv4_b, SHORT_PAD_L, SHORT_PAD_R)
    xr_c = _dwconv(xr_c, conv4_w, conv4_b, SHORT_PAD_L, SHORT_PAD_R)
    rec_l = []
    rec_c = []
    for d, rev in ((0, False), (1, True)):
        h_c = _rglru(xr_c, w_rg[d], b_rg[d], w_ig[d], b_ig[d], lam[d], None, rev)
        h0 = h_c[:, 0] if rev else h_c[:, -1]
        h_l = _rglru(xr_l, w_rg[d], b_rg[d], w_ig[d], b_ig[d], lam[d], h0, rev)
        rec_l.append(h_l)
        rec_c.append(h_c)
    y_rec_l = (rec_l[0] + rec_l[1]).astype(h_lat.dtype) * jax.nn.gelu(gr_l)
    y_conv_l = _conv_module(cv_l, cg_l, conv31_w, conv31_b, cln_g, cln_b, rows)
    y_lat = jnp.concatenate([y_rec_l, y_conv_l], axis=-1) @ w_out + b_out
    if not ctx_out:
        return y_lat, None
    y_rec_c = (rec_c[0] + rec_c[1]).astype(h_ctx.dtype) * jax.nn.gelu(gr_c)
    y_conv_c = _conv_module(cv_c, cg_c, conv31_w, conv31_b, cln_g, cln_b, 1)
    y_ctx = jnp.concatenate([y_rec_c, y_conv_c], axis=-1) @ w_out + b_out
    return y_lat, y_ctx


def setup_inputs(seed: int = 0) -> dict:
    key = jax.random.key(seed)
    ks = jax.random.split(key, 32)

    def nrm(k, shape, scale):
        return jax.random.normal(k, shape, jnp.float32) * scale

    x = nrm(ks[0], (BATCH, SEQ, D_MODEL), 1.0)
    c = nrm(ks[1], (BATCH, D_MODEL), 1.0)
    ctx = nrm(ks[2], (BATCH, CTX_LEN, D_MODEL), 1.0)
    c_ctx = nrm(ks[3], (D_MODEL,), 1.0)
    w_ada = nrm(ks[4], (DEPTH, D_MODEL, N_MOD * D_MODEL), ADA_SCALE * D_MODEL ** -0.5)
    b_ada = nrm(ks[5], (DEPTH, N_MOD * D_MODEL), 0.02)
    ln_g = 1.0 + nrm(ks[6], (DEPTH, 3, D_MODEL), 0.02)
    ln_b = nrm(ks[7], (DEPTH, 3, D_MODEL), 0.02)
    ff1_in = nrm(ks[8], (DEPTH, D_MODEL, 2 * D_FF), D_MODEL ** -0.5)
    ff1_out = nrm(ks[9], (DEPTH, D_FF, D_MODEL), BETA * D_FF ** -0.5)
    ff2_in = nrm(ks[10], (DEPTH, D_MODEL, 2 * D_FF), D_MODEL ** -0.5)
    ff2_out = nrm(ks[11], (DEPTH, D_FF, D_MODEL), BETA * D_FF ** -0.5)
    w_in = nrm(ks[12], (DEPTH, D_MODEL, D_IN), D_MODEL ** -0.5)
    conv4_w = nrm(ks[13], (DEPTH, CONV_SHORT, D_LRU), CONV_SHORT ** -0.5)
    conv4_b = nrm(ks[14], (DEPTH, D_LRU), 0.02)
    w_rg = nrm(ks[15], (DEPTH, 2, N_LRU_HEADS, LRU_HEAD_DIM, LRU_HEAD_DIM), LRU_HEAD_DIM ** -0.5)
    b_rg = nrm(ks[16], (DEPTH, 2, D_LRU), 0.02)
    w_ig = nrm(ks[17], (DEPTH, 2, N_LRU_HEADS, LRU_HEAD_DIM, LRU_HEAD_DIM), LRU_HEAD_DIM ** -0.5)
    b_ig = nrm(ks[18], (DEPTH, 2, D_LRU), 0.02)
    a_c = jax.random.uniform(ks[19], (DEPTH, 2, D_LRU), jnp.float32, minval=0.9, maxval=0.999)
    a_base = a_c ** (1.0 / RG_C)
    lam = jnp.log(a_base) - jnp.log1p(-a_base)
    conv31_w = nrm(ks[20], (DEPTH, CONV_K, D_CONV), CONV_K ** -0.5)
    conv31_b = nrm(ks[21], (DEPTH, D_CONV), 0.02)
    cln_g = 1.0 + nrm(ks[22], (DEPTH, D_CONV), 0.02)
    cln_b = nrm(ks[23], (DEPTH, D_CONV), 0.02)
    w_out = nrm(ks[24], (DEPTH, D_MIX, D_MODEL), BETA * D_MIX ** -0.5)
    b_out = nrm(ks[25], (DEPTH, D_MODEL), 0.02)
    return {'x': x, 'c': c, 'ctx': ctx, 'c_ctx': c_ctx, 'w_ada': w_ada, 'b_ada': b_ada,
            'ln_g': ln_g, 'ln_b': ln_b, 'ff1_in': ff1_in, 'ff1_out': ff1_out,
            'ff2_in': ff2_in, 'ff2_out': ff2_out, 'w_in': w_in, 'conv4_w': conv4_w,
            'conv4_b': conv4_b, 'w_rg': w_rg, 'b_rg': b_rg, 'w_ig': w_ig, 'b_ig': b_ig,
            'lam': lam, 'conv31_w': conv31_w, 'conv31_b': conv31_b, 'cln_g': cln_g,
            'cln_b': cln_b, 'w_out': w_out, 'b_out': b_out}


def reference(x, c, ctx, c_ctx, w_ada, b_ada, ln_g, ln_b, ff1_in, ff1_out, ff2_in, ff2_out,
              w_in, conv4_w, conv4_b, w_rg, b_rg, w_ig, b_ig, lam, conv31_w, conv31_b,
              cln_g, cln_b, w_out, b_out):
    rows = x.shape[1] // GRID_W
    for l in range(DEPTH):
        last = l == DEPTH - 1
        m = jnp.split((jax.nn.silu(c) @ w_ada[l] + b_ada[l])[:, None, :], N_MOD, axis=-1)
        mc = jnp.split((jax.nn.silu(c_ctx) @ w_ada[l] + b_ada[l])[None, None, :], N_MOD, axis=-1)
        x = _half_ffn(x, m[0], m[1], m[2], ff1_in[l], ff1_out[l], ln_g[l, 0], ln_b[l, 0])
        ctx = _half_ffn(ctx, mc[0], mc[1], mc[2], ff1_in[l], ff1_out[l], ln_g[l, 0], ln_b[l, 0])
        y_lat, y_ctx = _mixer(_modulate(x, m[3], m[4]), _modulate(ctx, mc[3], mc[4]), rows,
                              w_in[l], conv4_w[l], conv4_b[l], w_rg[l], b_rg[l], w_ig[l], b_ig[l],
                              lam[l], conv31_w[l], conv31_b[l], cln_g[l], cln_b[l], w_out[l],
                              b_out[l], not last)
        x = _layernorm(ALPHA * x + m[5] * y_lat, ln_g[l, 1], ln_b[l, 1])
        if not last:
            ctx = _layernorm(ALPHA * ctx + mc[5] * y_ctx, ln_g[l, 1], ln_b[l, 1])
            ctx = _half_ffn(ctx, mc[6], mc[7], mc[8], ff2_in[l], ff2_out[l], ln_g[l, 2], ln_b[l, 2])
        x = _half_ffn(x, m[6], m[7], m[8], ff2_in[l], ff2_out[l], ln_g[l, 2], ln_b[l, 2])
    return x
```

```cpp
#include <hip/hip_runtime.h>
#include <cstdio>
#include <cstdint>
namespace pg8 {
#define PG8_LAS __attribute__((address_space(3)))
typedef unsigned short bf16_t;
typedef short bf16x8 __attribute__((ext_vector_type(8)));
typedef float f32x4 __attribute__((ext_vector_type(4)));
typedef float f32x2 __attribute__((ext_vector_type(2)));
typedef unsigned u32x4 __attribute__((ext_vector_type(4)));
typedef unsigned u32x2 __attribute__((ext_vector_type(2)));
constexpr int BM = 256, BK = 64, HALF = 128, HTB = HALF * BK * 2  , STAGE_BYTES = 8 * HTB, NXCD = 8, WGM = 8;

__host__ __device__ __forceinline__ int lds_byte(int r, int c) { const int st = (r >> 4) * 2 + (c >> 5), rr = r & 15, cc = c & 31, ob = rr * 64 + cc * 2; return st * 1024 + (ob ^ (((ob >> 9) & 1) << 5)); }
__host__ __device__ __forceinline__ void stage_rc(int b, int& R, int& C) { const int st = b / 1024, sb = b % 1024, swz = sb ^ (((sb >> 9) & 1) << 5); R = (st >> 1) * 16 + swz / 64; C = (st & 1) * 32 + (swz % 64) / 2; }
__host__ __device__ __forceinline__ int perm32(int rho) { const int n = rho >> 4, i = rho & 15; return 8 * (i >> 2) + 4 * n + (i & 3); }

struct Unit { int pm, pn, ks; };
struct Gemm { const bf16_t* A; const bf16_t* Bt; int M, N, K, lda, ldb, ksA, ksB; };

struct StaticOrder {
    int nM, nN, nwg, G, c, ks_shift;
    __host__ __device__ void init(int M, int N, int G_, int c_, int ks_shift_ = 31) { nM = M / BM; nN = N / BM; nwg = nM * nN; G = G_; c = c_; ks_shift = ks_shift_; }
    __host__ __device__ bool next(int i, Unit& u) const {
        const long L = (long)i * G + c; if (L >= nwg) return false;
        int wgid = (int)L; { const int q = nwg / NXCD, r = nwg % NXCD, xcd = wgid % NXCD, off = wgid / NXCD; wgid = (xcd < r ? xcd * (q + 1) : r * (q + 1) + (xcd - r) * q) + off; }
        const int nig = WGM * nN, gid = wgid / nig, fm = gid * WGM, gsz = (nM - fm) < WGM ? (nM - fm) : WGM;
        u.pm = fm + ((wgid % nig) % gsz); u.pn = (wgid % nig) / gsz; u.ks = u.pn >> ks_shift; return true;
    }
    __device__ __forceinline__ void a_ready(const Unit&) const {}
    __device__ __forceinline__ void done(const Unit&) const {}
};

struct SplitKOrder {
    int pm0, nP, nN, KS, G, c;
    __device__ __forceinline__ bool next(int i, Unit& u) const { const int L = i * G + c; if (L >= nP * nN * KS) return false; u.ks = L % KS; const int t = L / KS; u.pn = t % nN; u.pm = pm0 + t / nN; return true; }
    __device__ __forceinline__ void a_ready(const Unit&) const {}
    __device__ __forceinline__ void done(const Unit&) const {}
};

typedef __bf16 bf16x2_t __attribute__((ext_vector_type(2)));
__device__ __forceinline__ unsigned cvt_pk_bf16(float lo, float hi) { f32x2 v = {lo, hi}; bf16x2_t b = __builtin_convertvector(v, bf16x2_t); return __builtin_bit_cast(unsigned, b); }
__device__ __forceinline__ float fast_sigmoid(float x) { return __builtin_amdgcn_rcpf(1.0f + __builtin_amdgcn_exp2f(-1.4426950408889634f * x)); }

struct EpiF32 {
    static constexpr bool PERM = false, AFTER_DRAIN = false;
    float* C0; int ldc, pm0; size_t ks_stride;
    __device__ __forceinline__ void operator()(const f32x4 (&acc)[2][2][4][2], const Unit& u, int wr, int wc, int fr, int fq) const {
        float* C = C0 + (size_t)u.ks * ks_stride;
        const int row0 = (u.pm - pm0) * BM + wr * 64 + fr, col0 = u.pn * BM + wc * 32 + 4 * fq;
#pragma unroll
        for (int ai = 0; ai < 2; ++ai)
#pragma unroll
            for (int m = 0; m < 4; ++m) { float* rowp = C + (size_t)(row0 + ai * HALF + m * 16) * ldc + col0;
#pragma unroll
                for (int bj = 0; bj < 2; ++bj)
#pragma unroll
                    for (int n = 0; n < 2; ++n) *(f32x4*)(rowp + bj * HALF + n * 16) = acc[ai][bj][m][n]; }
    }
};
struct EpiBf16P {
    static constexpr bool PERM = true, AFTER_DRAIN = false;
    bf16_t* O; int ldc;
    __device__ __forceinline__ void operator()(const f32x4 (&acc)[2][2][4][2], const Unit& u, int wr, int wc, int fr, int fq) const {
        const int row0 = u.pm * BM + wr * 64 + fr, col0 = u.pn * BM + wc * 32 + 8 * fq;
#pragma unroll
        for (int ai = 0; ai < 2; ++ai)
#pragma unroll
            for (int m = 0; m < 4; ++m) { bf16_t* rowp = O + (size_t)(row0 + ai * HALF + m * 16) * ldc + col0;
#pragma unroll
                for (int bj = 0; bj < 2; ++bj) { const f32x4 v0 = acc[ai][bj][m][0], v1 = acc[ai][bj][m][1];
                    u32x4 w; w.x = cvt_pk_bf16(v0[0], v0[1]); w.y = cvt_pk_bf16(v0[2], v0[3]); w.z = cvt_pk_bf16(v1[0], v1[1]); w.w = cvt_pk_bf16(v1[2], v1[3]);
                    *(u32x4*)(rowp + bj * HALF) = w; } }
    }
};
struct EpiSwiGLU {
    static constexpr bool PERM = true, AFTER_DRAIN = false;
    bf16_t* O; int ldo;
    __device__ __forceinline__ void operator()(const f32x4 (&acc)[2][2][4][2], const Unit& u, int wr, int wc, int fr, int fq) const {
        const int row0 = u.pm * BM + wr * 64 + fr, col0 = u.pn * HALF + wc * 32 + 8 * fq;
#pragma unroll
        for (int ai = 0; ai < 2; ++ai)
#pragma unroll
            for (int m = 0; m < 4; ++m) { bf16_t* rowp = O + (size_t)(row0 + ai * HALF + m * 16) * ldo + col0;
                float h[8];
#pragma unroll
                for (int n = 0; n < 2; ++n)
#pragma unroll
                    for (int e = 0; e < 4; ++e) { const float gt = acc[ai][0][m][n][e], up = acc[ai][1][m][n][e]; h[4 * n + e] = gt * up * fast_sigmoid(gt); }
                u32x4 w; w.x = cvt_pk_bf16(h[0], h[1]); w.y = cvt_pk_bf16(h[2], h[3]); w.z = cvt_pk_bf16(h[4], h[5]); w.w = cvt_pk_bf16(h[6], h[7]);
                *(u32x4*)rowp = w; }
    }
};
struct EpiGates {
    static constexpr bool PERM = true, AFTER_DRAIN = false;
    bf16_t* G; const float* br; const float* bi;
    __device__ __forceinline__ void operator()(const f32x4 (&acc)[2][2][4][2], const Unit& u, int wr, int wc, int fr, int fq) const {
        const int row0 = u.pm * BM + wr * 64 + fr; const int hh = u.pn >> 2, d = (u.pn >> 1) & 1, half = u.pn & 1;
        const int c0 = 256 * hh + 128 * half + 32 * wc + 8 * fq;
        const f32x4 br0 = *(const f32x4*)(br + d * 1024 + c0), br1 = *(const f32x4*)(br + d * 1024 + c0 + 4), bi0 = *(const f32x4*)(bi + d * 1024 + c0), bi1 = *(const f32x4*)(bi + d * 1024 + c0 + 4);
#pragma unroll
        for (int ai = 0; ai < 2; ++ai)
#pragma unroll
            for (int m = 0; m < 4; ++m) { bf16_t* rowp = G + (size_t)(row0 + ai * HALF + m * 16) * 4096 + (2 * d) * 1024 + c0; float sr[8], si[8];
#pragma unroll
                for (int q = 0; q < 8; ++q) {
                    const float xr = acc[ai][0][m][q >> 2][q & 3] + (q < 4 ? br0[q & 3] : br1[q & 3]), xi = acc[ai][1][m][q >> 2][q & 3] + (q < 4 ? bi0[q & 3] : bi1[q & 3]);
                    const float er = 1.0f + __builtin_amdgcn_exp2f(fminf(-1.4426950408889634f * xr, 60.f)), ei = 1.0f + __builtin_amdgcn_exp2f(fminf(-1.4426950408889634f * xi, 60.f));
                    const float rc = __builtin_amdgcn_rcpf(er * ei); sr[q] = ei * rc; si[q] = er * rc; }
                u32x4 w; w.x = cvt_pk_bf16(sr[0], sr[1]); w.y = cvt_pk_bf16(sr[2], sr[3]); w.z = cvt_pk_bf16(sr[4], sr[5]); w.w = cvt_pk_bf16(sr[6], sr[7]);
                *(u32x4*)rowp = w;
                w.x = cvt_pk_bf16(si[0], si[1]); w.y = cvt_pk_bf16(si[2], si[3]); w.z = cvt_pk_bf16(si[4], si[5]); w.w = cvt_pk_bf16(si[6], si[7]);
                *(u32x4*)(rowp + 1024) = w;
                if (m & 1) asm volatile("" ::: "memory"); }
    }
};

template <class Epi, class Sched, bool ALIGN_EPI = false, bool SP2 = false>
__device__ __forceinline__ void gemm_phase(PG8_LAS unsigned char* lds, const Gemm g, const Sched& S, const Epi& E) {
    int tid_ = threadIdx.x; asm volatile("" : "+v"(tid_));
    const int tid = tid_, wid = __builtin_amdgcn_readfirstlane(tid >> 6), lane = tid & 63, wr = wid >> 2, wc = wid & 3, fr = lane & 15, fq = lane >> 4;
    const int K = g.K, nt = K / BK;
    unsigned voffA[2], voffB[2];
#pragma unroll
    for (int i = 0; i < 2; ++i) { int R, C; stage_rc(tid * 16 + i * 8192, R, C); const int Rb = Epi::PERM ? ((R & ~31) + perm32(R & 31)) : R;
        voffA[i] = (unsigned)(R * g.lda + C) * 2u; voffB[i] = (unsigned)(Rb * g.ldb + C) * 2u; }
    const size_t kstep = (size_t)(BK * 2);
    const size_t hsA = (size_t)HALF * g.lda * 2, hsB = (size_t)HALF * g.ldb * 2;
    const size_t tsA = 2 * hsA, tsB = 2 * hsB;
    const unsigned ldsw = (unsigned)wid * 1024u;
    const int aoff = lds_byte(wr * 64 + fr, fq * 8), boff = lds_byte(wc * 32 + fr, fq * 8);
#define PG8_SA(b, h) (((b) * 2 + (h)) * HTB)
#define PG8_SB(b, h) ((4 + (b) * 2 + (h)) * HTB)
#define PG8_STAGE(bufoff, gbase, voff) do { _Pragma("unroll") for (int _i = 0; _i < 2; ++_i) \
        __builtin_amdgcn_global_load_lds((const unsigned*)((const char*)(gbase) + (voff)[_i]), (PG8_LAS unsigned*)(lds + (bufoff) + ldsw + _i * 8192), 16, 0, 0); } while (0)
#define PG8_LDA(dst, b, h) do { _Pragma("unroll") for (int m = 0; m < 4; ++m) _Pragma("unroll") for (int k = 0; k < 2; ++k) dst[m][k] = *(const PG8_LAS bf16x8*)(lds + PG8_SA(b, h) + aoff + m * 2048 + k * 1024); } while (0)
#define PG8_LDB(dst, b, h) do { _Pragma("unroll") for (int n = 0; n < 2; ++n) _Pragma("unroll") for (int k = 0; k < 2; ++k) dst[n][k] = *(const PG8_LAS bf16x8*)(lds + PG8_SB(b, h) + boff + n * 2048 + k * 1024); } while (0)
#define PG8_MMA(ai, bj, At, Bt) do { __builtin_amdgcn_s_setprio(1); _Pragma("unroll") for (int m = 0; m < 4; ++m) _Pragma("unroll") for (int n = 0; n < 2; ++n) _Pragma("unroll") for (int k = 0; k < 2; ++k) \
        acc[ai][bj][m][n] = __builtin_amdgcn_mfma_f32_16x16x32_bf16(Bt[n][k], At[m][k], acc[ai][bj][m][n], 0, 0, 0); __builtin_amdgcn_s_setprio(0); } while (0)
#define PG8_WAIT_V(n) asm volatile("s_waitcnt vmcnt(" #n ")" ::: "memory")
#define PG8_WAIT_L(n) asm volatile("s_waitcnt lgkmcnt(" #n ")" ::: "memory")
#define PG8_BAR __builtin_amdgcn_s_barrier()
#define PG8_SCHED __builtin_amdgcn_sched_barrier(0)
    Unit cur, nxt; int ui = 0;
    if (!S.next(0, cur)) return;
    f32x4 acc[2][2][4][2];
#pragma unroll
    for (int a = 0; a < 2; ++a)
#pragma unroll
        for (int b = 0; b < 2; ++b)
#pragma unroll
            for (int m = 0; m < 4; ++m)
#pragma unroll
                for (int n = 0; n < 2; ++n) acc[a][b][m][n] = (f32x4){0.f, 0.f, 0.f, 0.f};
    bf16x8 At[4][2], B0[2][2], B1[2][2];
    const char* cA = (const char*)g.A + (size_t)cur.pm * tsA + (size_t)cur.ks * g.ksA; const char* cB = (const char*)g.Bt + (size_t)cur.pn * tsB + (size_t)cur.ks * g.ksB;
    S.a_ready(cur);
    if constexpr (SP2) {
        PG8_STAGE(PG8_SB(0, 0), cB, voffB); PG8_STAGE(PG8_SB(0, 1), cB + hsB, voffB); PG8_STAGE(PG8_SA(0, 0), cA, voffA); PG8_STAGE(PG8_SA(0, 1), cA + hsA, voffA);
        if (wr == 1) PG8_BAR;
        PG8_WAIT_V(2); PG8_BAR;
        PG8_STAGE(PG8_SB(1, 0), cB + kstep, voffB); PG8_STAGE(PG8_SA(1, 0), cA + kstep, voffA); PG8_STAGE(PG8_SB(1, 1), cB + hsB + kstep, voffB);
        PG8_WAIT_V(6); PG8_BAR;
    } else {
        PG8_STAGE(PG8_SB(0, 0), cB, voffB); PG8_STAGE(PG8_SA(0, 0), cA, voffA); PG8_STAGE(PG8_SB(0, 1), cB + hsB, voffB); PG8_STAGE(PG8_SA(0, 1), cA + hsA, voffA);
        if (wr == 1) PG8_BAR;
        PG8_WAIT_V(4); PG8_BAR;
        PG8_STAGE(PG8_SB(1, 0), cB + kstep, voffB); PG8_STAGE(PG8_SA(1, 0), cA + kstep, voffA); PG8_STAGE(PG8_SB(1, 1), cB + hsB + kstep, voffB);
        PG8_WAIT_V(6); PG8_BAR;
    }
    for (;;) {
        const bool has_next = S.next(ui + 1, nxt);
        const char* nA = has_next ? (const char*)g.A + (size_t)nxt.pm * tsA + (size_t)nxt.ks * g.ksA : cA; const char* nB = has_next ? (const char*)g.Bt + (size_t)nxt.pn * tsB + (size_t)nxt.ks * g.ksB : cB;
        for (int t = 0; t < nt; t += 2) {
            const bool last = (t == nt - 2);
            const char* a1 = cA + (size_t)(t + 1) * kstep;
            const char* a2 = last ? nA : cA + (size_t)(t + 2) * kstep; const char* b2 = last ? nB : cB + (size_t)(t + 2) * kstep;
            const char* a3 = a2 + kstep; const char* b3 = b2 + kstep;
            if (last && has_next) S.a_ready(nxt);
            if constexpr (SP2) {
            PG8_LDB(B0, 0, 0); PG8_LDB(B1, 0, 1); PG8_SCHED; PG8_LDA(At, 0, 0); PG8_STAGE(PG8_SA(1, 1), a1 + hsA, voffA);
            PG8_WAIT_V(8); PG8_WAIT_L(0); PG8_BAR; PG8_MMA(0, 0, At, B0); PG8_MMA(0, 1, At, B1); PG8_BAR; PG8_SCHED;
            PG8_LDA(At, 0, 1); PG8_STAGE(PG8_SB(0, 0), b2, voffB); PG8_STAGE(PG8_SB(0, 1), b2 + hsB, voffB); PG8_STAGE(PG8_SA(0, 0), a2, voffA);
            PG8_WAIT_V(8); PG8_WAIT_L(0); PG8_BAR; PG8_MMA(1, 0, At, B0); PG8_MMA(1, 1, At, B1); PG8_BAR; PG8_SCHED;
            PG8_LDB(B0, 1, 0); PG8_LDB(B1, 1, 1); PG8_SCHED; PG8_LDA(At, 1, 0); PG8_STAGE(PG8_SA(0, 1), a2 + hsA, voffA);
            PG8_WAIT_V(8); PG8_WAIT_L(0); PG8_BAR; PG8_MMA(0, 0, At, B0); PG8_MMA(0, 1, At, B1); PG8_BAR; PG8_SCHED;
            PG8_LDA(At, 1, 1); PG8_STAGE(PG8_SB(1, 0), b3, voffB); PG8_STAGE(PG8_SB(1, 1), b3 + hsB, voffB); PG8_STAGE(PG8_SA(1, 0), a3, voffA);
            PG8_WAIT_V(8); PG8_WAIT_L(0); PG8_BAR; PG8_MMA(1, 0, At, B0); PG8_MMA(1, 1, At, B1); PG8_BAR; PG8_SCHED;
            } else {
            PG8_LDB(B0, 0, 0); PG8_SCHED; PG8_LDA(At, 0, 0); PG8_STAGE(PG8_SA(1, 1), a1 + hsA, voffA);
            PG8_WAIT_L(8); PG8_BAR; PG8_WAIT_L(0); PG8_MMA(0, 0, At, B0); PG8_BAR; PG8_SCHED;
            PG8_LDB(B1, 0, 1); PG8_STAGE(PG8_SB(0, 0), b2, voffB);
            PG8_BAR; PG8_WAIT_L(0); PG8_MMA(0, 1, At, B1); PG8_BAR;
            PG8_LDA(At, 0, 1); PG8_STAGE(PG8_SA(0, 0), a2, voffA);
            PG8_BAR; PG8_WAIT_L(0); PG8_MMA(1, 0, At, B0); PG8_BAR; PG8_SCHED;
            PG8_STAGE(PG8_SB(0, 1), b2 + hsB, voffB);
            PG8_WAIT_V(6); PG8_BAR; PG8_MMA(1, 1, At, B1); PG8_BAR;
            PG8_LDB(B0, 1, 0); PG8_SCHED; PG8_LDA(At, 1, 0); PG8_STAGE(PG8_SA(0, 1), a2 + hsA, voffA);
            PG8_WAIT_L(8); PG8_BAR; PG8_WAIT_L(0); PG8_MMA(0, 0, At, B0); PG8_BAR; PG8_SCHED;
            PG8_LDB(B1, 1, 1); PG8_STAGE(PG8_SB(1, 0), b3, voffB);
            PG8_BAR; PG8_WAIT_L(0); PG8_MMA(0, 1, At, B1); PG8_BAR;
            PG8_LDA(At, 1, 1); PG8_STAGE(PG8_SA(1, 0), a3, voffA);
            PG8_BAR; PG8_WAIT_L(0); PG8_MMA(1, 0, At, B0); PG8_BAR; PG8_SCHED;
            PG8_STAGE(PG8_SB(1, 1), b3 + hsB, voffB);
            PG8_WAIT_V(6); PG8_BAR; PG8_MMA(1, 1, At, B1); PG8_BAR;
            }
        }
        if constexpr (ALIGN_EPI) { if (wr == 0) PG8_BAR; }
        if constexpr (!Epi::AFTER_DRAIN) { E(acc, cur, wr, wc, fr, fq); S.done(cur); }
        if (!has_next) break;
#pragma unroll
        for (int a = 0; a < 2; ++a)
#pragma unroll
            for (int b = 0; b < 2; ++b)
#pragma unroll
                for (int m = 0; m < 4; ++m)
#pragma unroll
                    for (int n = 0; n < 2; ++n) acc[a][b][m][n] = (f32x4){0.f, 0.f, 0.f, 0.f};
        cur = nxt; cA = nA; cB = nB; ++ui;
        if constexpr (ALIGN_EPI) { if (wr == 1) PG8_BAR; }
    }
    PG8_WAIT_V(0);
    if constexpr (!ALIGN_EPI) { if (wr == 0) PG8_BAR; }
    PG8_BAR;
    if constexpr (Epi::AFTER_DRAIN) { E.fused(acc, cur, wr, wc, fr, fq, lds, wid, lane); S.done(cur); }
#undef PG8_SA
#undef PG8_SB
#undef PG8_STAGE
#undef PG8_LDA
#undef PG8_LDB
#undef PG8_MMA
#undef PG8_WAIT_V
#undef PG8_WAIT_L
#undef PG8_BAR
#undef PG8_SCHED
}
}

constexpr int NWAVES = 8;
constexpr int D = 2048, BATCH = 2, SEQ = 8192, CTXL = 256, DEPTH = 2;
constexpr int RL = BATCH * SEQ, RC = BATCH * CTXL, R = RL + RC;
constexpr int DFF = 5632, NFF = 2 * DFF, DLRU = 1024, DCONV = 1024, DIN = 4096, NMOD = 9, NADA = NMOD * D;
constexpr int CONVK = 31, GRIDW = 64;
constexpr float LN_EPS = 1e-6f, ALPHA = 1.41421356237309515f;
constexpr int SUBL = 32, NSUB = R / SUBL;
#ifndef MK_PER_PHASE
#define MK_PER_PHASE 0
#endif
constexpr int N_PHASES = 2 + 14 * DEPTH;
constexpr int KS_FFN = 11, KS_WOUT = 8, KS_MIX = 8;

enum { I_X = 0, I_C, I_CTX, I_CCTX, I_WADA, I_BADA, I_LNG, I_LNB, I_FF1IN, I_FF1OUT, I_FF2IN, I_FF2OUT, I_WIN, I_C4W, I_C4B, I_WRG, I_BRG, I_WIG, I_BIG, I_LAM, I_C31W, I_C31B, I_CLNG, I_CLNB, I_WOUT, I_BOUT, N_IN };

constexpr size_t MiB = 1u << 20;
constexpr size_t WS_CTL = 0, CTL_ZERO_BYTES = 1 * MiB;
constexpr size_t WS_MOD = 1 * MiB;
constexpr size_t WS_SA = 2 * MiB, WS_SB = 7 * MiB, WS_HIN = 12 * MiB;
constexpr size_t WS_W1T = 17 * MiB;
constexpr size_t WS_W2T = 193 * MiB;
constexpr size_t WS_WINT = 281 * MiB;
constexpr size_t WS_WOUTT = 313 * MiB;
constexpr size_t WS_WGT = 329 * MiB;
constexpr size_t WS_XS = 333 * MiB;
constexpr size_t WS_A = 465 * MiB;
constexpr size_t WS_F = 531 * MiB;
constexpr size_t WS_HID = 663 * MiB;
constexpr size_t WS_Y = 845 * MiB;
constexpr size_t WS_SLAB = 911 * MiB;
constexpr size_t WS_PSLAB = 955 * MiB;
constexpr size_t WS_END = 1019 * MiB;
static_assert(WS_W1T + (size_t)4 * NFF * D * 2 <= WS_W2T && WS_W2T + (size_t)4 * D * DFF * 2 <= WS_WINT && WS_WINT + (size_t)2 * DIN * D * 2 <= WS_WOUTT && WS_WOUTT + (size_t)2 * D * D * 2 <= WS_WGT && WS_WGT + (size_t)2 * 4096 * 256 * 2 <= WS_XS, "ws map (weights)");
static_assert(WS_XS + (size_t)R * D * 4 <= WS_A && WS_A + (size_t)R * D * 2 <= WS_F && WS_F + (size_t)R * D * 4 <= WS_HID && WS_HID + (size_t)R * DFF * 2 <= WS_Y && WS_Y + (size_t)R * D * 2 <= WS_SLAB && WS_SLAB + (size_t)11 * RC * D * 4 <= WS_PSLAB && WS_PSLAB + (size_t)8 * RC * DIN * 4 <= WS_END, "ws map (activations)");
static_assert((size_t)R * DIN * 2 <= (size_t)R * D * 4 && (size_t)R * 4096 * 2 + (size_t)R * 1024 * 2 <= (size_t)R * DFF * 2 && (size_t)NSUB * 2 * 1024 * 4 <= 5 * MiB, "ws overlays");
constexpr int CW_TMO = 0, CW_CODE = 1, CW_BAR = 4096, CW_Q = 8192;

constexpr int RING_OFF = 0, RING_BYTES = 131072;
constexpr int LDSCTL_OFF = RING_BYTES, MISC_OFF = LDSCTL_OFF + 320;
constexpr int LDS_BYTES = 147456;

#define GAS __attribute__((address_space(1)))
#define LAS __attribute__((address_space(3)))
typedef unsigned short bf16;
typedef unsigned v4u __attribute__((ext_vector_type(4)));
typedef unsigned v2u __attribute__((ext_vector_type(2)));
typedef float f32x4 __attribute__((ext_vector_type(4)));
typedef float f32x2 __attribute__((ext_vector_type(2)));
typedef GAS unsigned gu32;
typedef _Float16 f16x4 __attribute__((ext_vector_type(4)));
#define RLX_AGENT __ATOMIC_RELAXED, __HIP_MEMORY_SCOPE_AGENT
#define LDS_WAIT() asm volatile("s_waitcnt lgkmcnt(0)" ::: "memory")
#define VM_WAIT() asm volatile("s_waitcnt vmcnt(0)" ::: "memory")
__device__ __forceinline__ unsigned f2bf(float f) { unsigned u = __builtin_bit_cast(unsigned, f); return (u + 0x7fffu + ((u >> 16) & 1u)) >> 16; }
__device__ __forceinline__ unsigned pk2(float lo, float hi) { return pg8::cvt_pk_bf16(lo, hi); }
__device__ __forceinline__ float bflo(unsigned u) { return __uint_as_float(u << 16); }
__device__ __forceinline__ float bfhi(unsigned u) { return __uint_as_float(u & 0xffff0000u); }
__device__ __forceinline__ float sigm(float x) { return __builtin_amdgcn_rcpf(1.0f + __builtin_amdgcn_exp2f(-1.4426950408889634f * x)); }
template <int CTRL> __device__ __forceinline__ float dpp_mov(float v) { return __builtin_bit_cast(float, __builtin_amdgcn_update_dpp(0, __builtin_bit_cast(int, v), CTRL, 0xf, 0xf, true)); }
__device__ __forceinline__ float wave_sum(float v) {
    v += dpp_mov<0xB1>(v); v += dpp_mov<0x4E>(v); v += dpp_mov<0x141>(v); v += dpp_mov<0x140>(v);
    { auto r = __builtin_amdgcn_permlane16_swap(__float_as_uint(v), __float_as_uint(v), false, false); v = __uint_as_float(r[0]) + __uint_as_float(r[1]); }
    { auto r = __builtin_amdgcn_permlane32_swap(__float_as_uint(v), __float_as_uint(v), false, false); v = __uint_as_float(r[0]) + __uint_as_float(r[1]); }
    return v;
}

#define XB_TMO      128
#define XB_XCNT(j)  (256  + 64 * (j))
#define XB_XSUB(j)  (1280 + 64 * (j))
#define XB_XGEN(j)  (2304 + 64 * (j))
#define XB_TOP      3328
#define XB_TOPGEN   3392
#define XCD_BAR_WORDS 3456
#define XB_SPIN_CAP (1u << 18)

__device__ __forceinline__ unsigned xb_ld(unsigned* p)              { return __hip_atomic_load(p, __ATOMIC_RELAXED, __HIP_MEMORY_SCOPE_AGENT); }
__device__ __forceinline__ unsigned xb_add(unsigned* p, unsigned v) { return __hip_atomic_fetch_add(p, v, __ATOMIC_RELAXED, __HIP_MEMORY_SCOPE_AGENT); }
__device__ __forceinline__ unsigned xb_xcc_id() { return (unsigned)__builtin_amdgcn_s_getreg((3 << 11) | 20) & 0xFu; }
#define XB_SPIN(cond, bar) do { unsigned _sp = 0; while (cond) { __builtin_amdgcn_s_sleep(1); \
    if ((++_sp & 255u) == 0u) { if (xb_ld(&(bar)[XB_TMO])) break; if (_sp > XB_SPIN_CAP) { atomicAdd(&(bar)[XB_TMO], 1u); break; } } } } while (0)

struct XcdBarrier {
    unsigned* bar; unsigned x;
    volatile LAS unsigned* st;
};
__device__ __forceinline__ XcdBarrier xcd_barrier_post(unsigned* bar, volatile LAS unsigned* st) {
    XcdBarrier b; b.bar = bar; b.x = xb_xcc_id(); b.st = st;
    if (threadIdx.x == 0) (void)xb_add(&bar[XB_XCNT(b.x)], 1u);
    return b;
}
__device__ __forceinline__ void xcd_barrier_complete(unsigned* bar, unsigned x, unsigned& nloc, unsigned& nx) {
    const unsigned G = gridDim.x * gridDim.y * gridDim.z;
    unsigned sum, cnt, mine, sp = 0u;
    for (;;) {
        sum = 0u; cnt = 0u; mine = 0u;
#pragma unroll
        for (unsigned j = 0; j < 16; ++j) { const unsigned c = xb_ld(&bar[XB_XCNT(j)]); sum += c; cnt += (c > 0u) ? 1u : 0u; mine = (j == x) ? c : mine; }
        if (sum == G) break;
        __builtin_amdgcn_s_sleep(1);
        if ((++sp & 255u) == 0u) { if (xb_ld(&bar[XB_TMO])) break; if (sp > XB_SPIN_CAP) { atomicAdd(&bar[XB_TMO], 1u); break; } }
    }
    nloc = mine > 0u ? mine : 1u; nx = cnt > 0u ? cnt : 1u;
}
__device__ __forceinline__ void xcd_barrier(const XcdBarrier& b) {
    asm volatile("s_waitcnt vmcnt(0)" ::: "memory");
    __syncthreads();
    if (threadIdx.x == 0) {
        unsigned* bar = b.bar;
        __builtin_amdgcn_s_waitcnt(0);
        unsigned nloc = b.st[0], nx = b.st[1];
        if (nloc == 0u) { xcd_barrier_complete(bar, b.x, nloc, nx); b.st[0] = nloc; b.st[1] = nx; }
        const unsigned old = xb_add(&bar[XB_XSUB(b.x)], 1u);
        const unsigned gen = old / nloc;
        if (old + 1u == (gen + 1u) * nloc) {
            __builtin_amdgcn_fence(__ATOMIC_RELEASE, "agent");
            asm volatile("s_waitcnt vmcnt(0)" ::: "memory");
            const unsigned og = xb_add(&bar[XB_TOP], 1u);
            const unsigned tg = og / nx;
            if (og + 1u == (tg + 1u) * nx) xb_add(&bar[XB_TOPGEN], 1u);
            else XB_SPIN(xb_ld(&bar[XB_TOPGEN]) == tg, bar);
            __builtin_amdgcn_fence(__ATOMIC_ACQUIRE, "agent");
            xb_add(&bar[XB_XGEN(b.x)], 1u);
            asm volatile("s_waitcnt vmcnt(0)" ::: "memory");
        } else {
            XB_SPIN(xb_ld(&bar[XB_XGEN(b.x)]) == gen, bar);
            __builtin_amdgcn_fence(__ATOMIC_ACQUIRE, "agent");
            asm volatile("s_waitcnt vmcnt(0)" ::: "memory");
        }
    }
    __syncthreads();
}

struct Frame {
    LAS unsigned char* lds;
    gu32* ctl;
    int tid, lane, wave, G;
    const float* in[N_IN]; float* out;
    float* MOD; float *SA, *SB, *HIN;
    bf16 *W1T, *W2T, *WINT, *WOUTT, *WGT;
    _Float16* XS; bf16* A; bf16* Fb; bf16* P; bf16* HID; bf16* GT; bf16* XC; bf16* Y; float* SLAB; float* PSLAB;
};

__device__ __forceinline__ void fresh(Frame& F) { int t = threadIdx.x; asm volatile("" : "+v"(t)); F.tid = t; F.lane = t & 63; F.wave = __builtin_amdgcn_readfirstlane(t >> 6); }
__device__ __forceinline__ void transpose_item(const float* W, int ldw, int src_col, bf16* WT, int ldk, int dst_row, int k0, LAS float* scr, int lane) {
    const int c4 = (lane & 7) * 4, kr = lane >> 3; f32x4 v[8];
#pragma unroll
    for (int i = 0; i < 8; ++i) v[i] = *(const f32x4*)(W + (size_t)(k0 + 8 * i + kr) * ldw + src_col + c4);
#pragma unroll
    for (int i = 0; i < 8; ++i) { LAS float* d = scr + (8 * i + kr) * 33 + c4; d[0] = v[i][0]; d[1] = v[i][1]; d[2] = v[i][2]; d[3] = v[i][3]; }
    LDS_WAIT(); asm volatile("" ::: "memory");
    const int c = lane & 7;
#pragma unroll
    for (int j = 0; j < 4; ++j) { const int n = (lane >> 3) + 8 * j; const LAS float* s = scr + (8 * c) * 33 + n;
        v4u o; o.x = pk2(s[0 * 33], s[1 * 33]); o.y = pk2(s[2 * 33], s[3 * 33]); o.z = pk2(s[4 * 33], s[5 * 33]); o.w = pk2(s[6 * 33], s[7 * 33]);
        *(v4u*)(WT + (size_t)(dst_row + n) * ldk + k0 + 8 * c) = o; }
    LDS_WAIT(); asm volatile("" ::: "memory");
}
constexpr int IT_FIN = (D / 64) * (NFF / 32), IT_FOUT = (DFF / 64) * (D / 32), IT_WIN = (D / 64) * (DIN / 32), IT_WOUT = (D / 64) * (D / 32), IT_G = (256 / 64) * (4096 / 32);
constexpr int CV_LAYER_ITEMS = 2 * IT_FIN + 2 * IT_FOUT + IT_WIN + IT_WOUT + IT_G;
#ifndef CV_TAIL_PCT
#define CV_TAIL_PCT 100
#endif
constexpr int CV_TAIL_ITEMS = (int)((long)CV_LAYER_ITEMS * CV_TAIL_PCT / 100);
__device__ __forceinline__ void convert_layer_items(Frame& F, int l, int it_begin, int it_end, int widx, int nw) {
    LAS float* scr = (LAS float*)(F.lds + RING_OFF + F.wave * 16384);
    for (int it = it_begin + widx; it < it_end; it += nw) {
        int r = it;
#define CV_FIN(f) { const int kb = r / (NFF / 32), nb = r % (NFF / 32), dst_row = 32 * nb, pn = dst_row >> 8, lc = dst_row & 255, src_col = lc < 128 ? 128 * pn + lc : DFF + 128 * pn + (lc - 128); \
            transpose_item(F.in[(f) ? I_FF2IN : I_FF1IN] + (size_t)l * D * NFF, NFF, src_col, F.W1T + (size_t)(l * 2 + (f)) * NFF * D, D, dst_row, 64 * kb, scr, F.lane); continue; }
#define CV_FOUT(f) { const int kb = r / (D / 32), nb = r % (D / 32); \
            transpose_item(F.in[(f) ? I_FF2OUT : I_FF1OUT] + (size_t)l * DFF * D, D, 32 * nb, F.W2T + (size_t)(l * 2 + (f)) * D * DFF, DFF, 32 * nb, 64 * kb, scr, F.lane); continue; }
        if (r < IT_FIN) CV_FIN(0)
        r -= IT_FIN;
        if (r < IT_FOUT) CV_FOUT(0)
        r -= IT_FOUT;
        if (r < IT_WIN) { const int kb = r / (DIN / 32), nb = r % (DIN / 32);
            transpose_item(F.in[I_WIN] + (size_t)l * D * DIN, DIN, 32 * nb, F.WINT + (size_t)l * DIN * D, D, 32 * nb, 64 * kb, scr, F.lane); continue; }
        r -= IT_WIN;
        if (r < IT_G) { const int kb = r / 128, nb = r % 128; const int dst_row = 32 * nb, pn = dst_row >> 8, lc = dst_row & 255, hh = pn >> 2, d = (pn >> 1) & 1, half = pn & 1;
            const float* src = F.in[lc < 128 ? I_WRG : I_WIG] + (size_t)((l * 2 + d) * 4 + hh) * 65536;
            transpose_item(src, 256, 128 * half + (lc & 127), F.WGT + (size_t)l * 4096 * 256, 256, dst_row, 64 * kb, scr, F.lane); continue; }
        r -= IT_G;
        if (r < IT_WOUT) { const int kb = r / (D / 32), nb = r % (D / 32);
            transpose_item(F.in[I_WOUT] + (size_t)l * D * D, D, 32 * nb, F.WOUTT + (size_t)l * D * D, D, 32 * nb, 64 * kb, scr, F.lane); continue; }
        r -= IT_WOUT;
        if (r < IT_FIN) CV_FIN(1)
        r -= IT_FIN;
        CV_FOUT(1)
#undef CV_FIN
#undef CV_FOUT
    }
}
__device__ __forceinline__ void convert_in_tail(Frame& F, int lconv, int it_begin, int it_end, int nunits) {
    fresh(F);
    const int first = nunits % F.G, nwg = F.G - first;
    if ((int)blockIdx.x < first) return;
    convert_layer_items(F, lconv, it_begin, it_end, ((int)blockIdx.x - first) * NWAVES + F.wave, nwg * NWAVES);
}
constexpr int CV_S2 = IT_FIN + IT_FOUT + IT_WIN + IT_G + IT_WOUT, CV_S1 = CV_S2 / 2;
__device__ __forceinline__ void prologue_a(Frame& F) {
    fresh(F);
    {
        LAS float* sv = (LAS float*)(F.lds + RING_OFF);
        LAS float* red = (LAS float*)(F.lds + RING_OFF + 32768);
#pragma unroll
        for (int i = F.tid; i < 3 * D; i += NWAVES * 64) { const int v = i >> 11, k = i & (D - 1); const float cv = v < 2 ? F.in[I_C][v * D + k] : F.in[I_CCTX][k]; sv[i] = cv * sigm(cv); }
        __syncthreads();
        const int cg = F.lane & 15, rg = F.lane >> 4;
#ifndef DUP_ADA
#define DUP_ADA 0
#endif
        for (int rep2 = 0; rep2 <= DUP_ADA; ++rep2)
        for (int it = blockIdx.x; it < DEPTH * (NADA / 64); it += F.G) {
            const int l = it / (NADA / 64), n0 = (it % (NADA / 64)) * 64;
            const float* W = F.in[I_WADA] + (size_t)l * D * NADA + n0 + 4 * cg;
            f32x4 a0 = {0.f, 0.f, 0.f, 0.f}, a1 = a0, a2 = a0;
#pragma unroll 8
            for (int kk = 0; kk < 64; ++kk) { const int k = F.wave * 256 + kk * 4 + rg; const f32x4 w = *(const f32x4*)(W + (size_t)k * NADA);
                a0 += w * sv[k]; a1 += w * sv[D + k]; a2 += w * sv[2 * D + k]; }
#pragma unroll
            for (int e = 0; e < 4; ++e) { a0[e] += __shfl_xor(a0[e], 16); a0[e] += __shfl_xor(a0[e], 32); a1[e] += __shfl_xor(a1[e], 16); a1[e] += __shfl_xor(a1[e], 32); a2[e] += __shfl_xor(a2[e], 16); a2[e] += __shfl_xor(a2[e], 32); }
            if (rg == 0) {
#pragma unroll
                for (int e = 0; e < 4; ++e) { red[(F.wave * 3 + 0) * 64 + 4 * cg + e] = a0[e]; red[(F.wave * 3 + 1) * 64 + 4 * cg + e] = a1[e]; red[(F.wave * 3 + 2) * 64 + 4 * cg + e] = a2[e]; }
            }
            __syncthreads();
            if (F.tid < 192) { const int v = F.tid >> 6, n = F.tid & 63; float s = F.in[I_BADA][(size_t)l * NADA + n0 + n];
#pragma unroll
                for (int w = 0; w < 8; ++w) s += red[(w * 3 + v) * 64 + n];
                F.MOD[((size_t)l * 3 + v) * NADA + n0 + n] = s; }
            __syncthreads();
        }
    }
    convert_layer_items(F, 0, 0, CV_LAYER_ITEMS, blockIdx.x * NWAVES + F.wave, F.G * NWAVES);
}
__device__ __forceinline__ void init_phase(Frame& F) {
    fresh(F);
    const int gw = blockIdx.x * NWAVES + F.wave, NGW = F.G * NWAVES;
    for (int row0 = gw; row0 < R; row0 += 2 * NGW) {
        f32x4 xv[2][8];
#pragma unroll
        for (int h = 0; h < 2; ++h) { const int row = row0 + h * NGW; if (row < R) { const float* src = row < RL ? F.in[I_X] + (size_t)row * D : F.in[I_CTX] + (size_t)(row - RL) * D;
#pragma unroll
            for (int j = 0; j < 8; ++j) xv[h][j] = *(const f32x4*)(src + 4 * F.lane + 256 * j); } }
#pragma unroll
        for (int h = 0; h < 2; ++h) { const int row = row0 + h * NGW; if (row < R) { const float* m = F.MOD + (size_t)(row < RL ? (row >> 13) : 2) * NADA;
#pragma unroll
            for (int j = 0; j < 8; ++j) { const int col = 4 * F.lane + 256 * j; const f32x4 sh = *(const f32x4*)(m + col), sc = *(const f32x4*)(m + D + col);
                const f32x4 a = xv[h][j] * (1.0f + sc) + sh; v2u o; o.x = pk2(a[0], a[1]); o.y = pk2(a[2], a[3]);
                *(v2u*)(F.A + (size_t)row * D + col) = o; } } }
    }
}
__device__ __forceinline__ void ln_load(const float* xin, const _Float16* xh, const bf16* fb, const float* fs, int nks, int lane, f32x4 (&x)[8], f32x4 (&f)[8]) {
    if (xin) {
#pragma unroll
        for (int j = 0; j < 8; ++j) x[j] = *(const f32x4*)(xin + 4 * lane + 256 * j);
    } else {
#pragma unroll
        for (int j = 0; j < 8; ++j) { const f16x4 h = *(const f16x4*)(xh + 4 * lane + 256 * j); x[j] = (f32x4){(float)h[0], (float)h[1], (float)h[2], (float)h[3]}; }
    }
    if (nks == 0) {
#pragma unroll
        for (int j = 0; j < 8; ++j) { const v2u w = *(const v2u*)(fb + 4 * lane + 256 * j); f[j] = (f32x4){bflo(w.x), bfhi(w.x), bflo(w.y), bfhi(w.y)}; }
    } else {
#pragma unroll
        for (int j = 0; j < 8; ++j) f[j] = *(const f32x4*)(fs + 4 * lane + 256 * j);
        for (int ks = 1; ks < nks; ++ks) {
#pragma unroll
            for (int j = 0; j < 8; ++j) f[j] += *(const f32x4*)(fs + (size_t)ks * RC * D + 4 * lane + 256 * j); }
    }
}
__device__ __forceinline__ void ln_finish(f32x4 (&x)[8], const f32x4 (&f)[8], const LAS float* Tv, const LAS float* Tg, int lane, float* xo, _Float16* xho, bf16* ao) {
    float sum = 0.f;
#pragma unroll
    for (int j = 0; j < 8; ++j) { const int col = 4 * lane + 256 * j; const f32x4 gg = *(const LAS f32x4*)(Tv + col), bb = *(const LAS f32x4*)(Tv + D + col);
        x[j] = ALPHA * x[j] + (gg * f[j] + bb); sum += (x[j][0] + x[j][1]) + (x[j][2] + x[j][3]); if (j & 1) asm volatile("" ::: "memory"); }
    const float mean = wave_sum(sum) * (1.0f / D); float s2 = 0.f;
#pragma unroll
    for (int j = 0; j < 8; ++j) { x[j] = x[j] - mean; s2 += (x[j][0] * x[j][0] + x[j][1] * x[j][1]) + (x[j][2] * x[j][2] + x[j][3] * x[j][3]); }
    const float rstd = 1.0f / sqrtf(wave_sum(s2) * (1.0f / D) + LN_EPS);
#pragma unroll
    for (int j = 0; j < 8; ++j) { const int col = 4 * lane + 256 * j; const f32x4 n = x[j] * rstd;
        const f32x4 y = n * *(const LAS f32x4*)(Tg + col) + *(const LAS f32x4*)(Tg + D + col);
        if (xo) *(f32x4*)(xo + col) = y; else *(f16x4*)(xho + col) = (f16x4){(_Float16)y[0], (_Float16)y[1], (_Float16)y[2], (_Float16)y[3]};
        if (ao) { const f32x4 a = n * *(const LAS f32x4*)(Tv + 2 * D + col) + *(const LAS f32x4*)(Tv + 3 * D + col); v2u o; o.x = pk2(a[0], a[1]); o.y = pk2(a[2], a[3]); *(v2u*)(ao + col) = o; }
        if (j & 1) asm volatile("" ::: "memory"); }
}
__device__ __forceinline__ void ln_phase(Frame& F, int l, int s, bool dummy = false) {
    fresh(F);
    const bool last = (l == DEPTH - 1 && s == 2), first = (l == 0 && s == 0);
    const float gsc = (s == 1) ? 1.0f : 0.5f;
    const float* bias = (s == 1) ? F.in[I_BOUT] + (size_t)l * D : nullptr;
    const float* lg = F.in[I_LNG] + (size_t)(l * 3 + s) * D; const float* lb = F.in[I_LNB] + (size_t)(l * 3 + s) * D;
    const float* modl = F.MOD + (size_t)l * 3 * NADA;
    const float* modn = (s == 2) ? F.MOD + (size_t)(last ? l : l + 1) * 3 * NADA : modl;
    const int shi = (s == 2) ? 0 : 3 * s + 3;
    const int nrows = last ? RL : R;
    const int nks = (s == 1) ? KS_WOUT : KS_FFN;
    LAS float* T = (LAS float*)(F.lds + RING_OFF);
#pragma unroll
    for (int i = F.tid; i < 3 * D; i += NWAVES * 64) { const int v = i >> 11, col = i & (D - 1);
        const float gg = gsc * modl[(size_t)v * NADA + (3 * s + 2) * D + col], lgv = lg[col], lbv = lb[col];
        const float sh = modn[(size_t)v * NADA + shi * D + col], sc = modn[(size_t)v * NADA + (shi + 1) * D + col];
        T[(v * 4 + 0) * D + col] = gg; T[(v * 4 + 1) * D + col] = bias ? gg * bias[col] : 0.f; T[(v * 4 + 2) * D + col] = lgv * (1.0f + sc); T[(v * 4 + 3) * D + col] = lbv * (1.0f + sc) + sh;
        if (v == 0) { T[12 * D + col] = lgv; T[13 * D + col] = lbv; } }
    __syncthreads();
    const LAS float* Tg = T + 12 * D;
    const int l_begin = (int)((long)RL * blockIdx.x / F.G), l_end = (int)((long)RL * (blockIdx.x + 1) / F.G);
    const int c_begin = (int)((long)RC * blockIdx.x / F.G), nc = (l == DEPTH - 1 && s >= 1) ? 0 : (int)((long)RC * (blockIdx.x + 1) / F.G) - c_begin,     ntot = nc + (l_end - l_begin);
    LAS unsigned* ctr = (LAS unsigned*)(F.lds + MISC_OFF) + 16;
#define LN_GRAB(k_) do { unsigned g_ = 0u; if (F.lane == 0) g_ = __hip_atomic_fetch_add(ctr, 1u, __ATOMIC_RELAXED, __HIP_MEMORY_SCOPE_WORKGROUP); k_ = __builtin_amdgcn_readfirstlane((int)g_); } while (0)
#define LN_ROW(k_) ((k_) < nc ? RL + c_begin + (k_) : l_begin + ((k_) - nc))
#define LN_SRC(row, xin, fin, nk) const float* xin = first ? ((row) < RL ? F.in[I_X] + (size_t)(row) * D : F.in[I_CTX] + (size_t)((row) - RL) * D) : nullptr; const _Float16* xh = F.XS + (size_t)(row) * D; \
        const bf16* fb = F.Fb + (size_t)((row) < RL ? (row) : 0) * D; const float* fin = F.SLAB + (size_t)((row) < RL ? 0 : (row) - RL) * D; const int nk = (row) < RL ? 0 : nks;
#define LN_DST(row, Tv, xo, ao) const LAS float* Tv = T + ((row) < RL ? ((row) >> 13) : 2) * 4 * D; float* xo = last ? (dummy ? (float*)F.HID : F.out) + (size_t)(row) * D : nullptr; _Float16* xho = (dummy ? (_Float16*)F.HID : F.XS) + (size_t)(row) * D; bf16* ao = dummy ? F.Y + (size_t)(row) * D : last ? nullptr : F.A + (size_t)(row) * D;
    {
        f32x4 xa[8], fa[8], xb[8], fb_[8];
        int ka, kb; LN_GRAB(ka);
        if (ka < ntot) { const int rA = LN_ROW(ka); LN_SRC(rA, xin, fin, nk) ln_load(xin, xh, fb, fin, nk, F.lane, xa, fa); }
        while (ka < ntot) {
            LN_GRAB(kb);
            if (kb < ntot) { const int rB = LN_ROW(kb); LN_SRC(rB, xin, fin, nk) ln_load(xin, xh, fb, fin, nk, F.lane, xb, fb_); }
            asm volatile("" ::: "memory");
            { const int rA = LN_ROW(ka); LN_DST(rA, Tv, xo, ao) ln_finish(xa, fa, Tv, Tg, F.lane, xo, xho, ao); }
            asm volatile("" ::: "memory");
            if (kb >= ntot) break;
            LN_GRAB(ka);
            if (ka < ntot) { const int rA = LN_ROW(ka); LN_SRC(rA, xin, fin, nk) ln_load(xin, xh, fb, fin, nk, F.lane, xa, fa); }
            asm volatile("" ::: "memory");
            { const int rB = LN_ROW(kb); LN_DST(rB, Tv, xo, ao) ln_finish(xb, fb_, Tv, Tg, F.lane, xo, xho, ao); }
            asm volatile("" ::: "memory");
        }
    }
#undef LN_GRAB
#undef LN_ROW
#undef LN_SRC
#undef LN_DST
    __syncthreads();
    if (F.tid == 0) *ctr = 0u;
}
constexpr int CT = 16;
__device__ __forceinline__ void conv4_phase(Frame& F, int l) {
    fresh(F);
    {
        const float* w4 = F.in[I_C4W] + (size_t)l * 4 * DLRU; const float* b4 = F.in[I_C4B] + (size_t)l * DLRU;
        for (int idx = blockIdx.x * (NWAVES * 64) + F.tid; idx < R * (DLRU / 8); idx += F.G * NWAVES * 64) {
            const int row = idx >> 7, c8 = (idx & 127) * 8;
            int s0, s1; if (row < RL) { s0 = row & ~(SEQ - 1); s1 = s0 + SEQ; } else { s0 = RL + ((row - RL) & ~(CTXL - 1)); s1 = s0 + CTXL; }
            f32x4 a0 = *(const f32x4*)(b4 + c8), a1 = *(const f32x4*)(b4 + c8 + 4);
#pragma unroll
            for (int k = 0; k < 4; ++k) { const int rr = row + k - 2;
                if (rr >= s0 && rr < s1) { const f32x4 w0 = *(const f32x4*)(w4 + k * DLRU + c8), w1 = *(const f32x4*)(w4 + k * DLRU + c8 + 4); f32x4 x0, x1;
                    if (row < RL) { const v4u xv = *(const v4u*)(F.P + (size_t)rr * DIN + c8); x0 = (f32x4){bflo(xv.x), bfhi(xv.x), bflo(xv.y), bfhi(xv.y)}; x1 = (f32x4){bflo(xv.z), bfhi(xv.z), bflo(xv.w), bfhi(xv.w)}; }
                    else { const float* sp = F.PSLAB + (size_t)(rr - RL) * DIN + c8; x0 = *(const f32x4*)sp; x1 = *(const f32x4*)(sp + 4);
#pragma unroll
                        for (int ks = 1; ks < KS_MIX; ++ks) { x0 += *(const f32x4*)(sp + (size_t)ks * RC * DIN); x1 += *(const f32x4*)(sp + (size_t)ks * RC * DIN + 4); } }
                    a0 += w0 * x0; a1 += w1 * x1; } }
            v4u o; o.x = pk2(a0[0], a0[1]); o.y = pk2(a0[2], a0[3]); o.z = pk2(a1[0], a1[1]); o.w = pk2(a1[2], a1[3]);
            *(v4u*)(F.XC + (size_t)row * DLRU + c8) = o;
        }
    }
    if (l != DEPTH - 1) {
        for (int idx = blockIdx.x * (NWAVES * 64) + F.tid; idx < RC * ((DIN - DLRU) / 8); idx += F.G * NWAVES * 64) {
            const int rc = idx / ((DIN - DLRU) / 8), c8 = DLRU + (idx % ((DIN - DLRU) / 8)) * 8;
            const float* sp = F.PSLAB + (size_t)rc * DIN + c8; f32x4 x0 = *(const f32x4*)sp, x1 = *(const f32x4*)(sp + 4);
#pragma unroll
            for (int ks = 1; ks < KS_MIX; ++ks) { x0 += *(const f32x4*)(sp + (size_t)ks * RC * DIN); x1 += *(const f32x4*)(sp + (size_t)ks * RC * DIN + 4); }
            v4u o; o.x = pk2(x0[0], x0[1]); o.y = pk2(x0[2], x0[3]); o.z = pk2(x1[0], x1[1]); o.w = pk2(x1[2], x1[3]);
            *(v4u*)(F.P + (size_t)(RL + rc) * DIN + c8) = o;
        }
    }
}
__device__ __forceinline__ void conv31_phase(Frame& F, int l) {
    fresh(F);
    {
        const float* w31 = F.in[I_C31W] + (size_t)l * CONVK * DCONV; const float* b31 = F.in[I_C31B] + (size_t)l * DCONV;
        const float* cg_ = F.in[I_CLNG] + (size_t)l * DCONV; const float* cb_ = F.in[I_CLNB] + (size_t)l * DCONV;
        LAS f32x2* red = (LAS f32x2*)(F.lds + RING_OFF);
        LAS f32x2* stat = (LAS f32x2*)(F.lds + RING_OFF + 4096);
        const int cp = F.tid;
        f32x2 w[CONVK];
#pragma unroll
        for (int k = 0; k < CONVK; ++k) w[k] = *(const f32x2*)(w31 + k * DCONV + 2 * cp);
        const f32x2 bb = *(const f32x2*)(b31 + 2 * cp), lng = *(const f32x2*)(cg_ + 2 * cp), lnb = *(const f32x2*)(cb_ + 2 * cp);
        const int nitems = ((l == DEPTH - 1) ? RL : R) / CT;
        LAS int* itl = (LAS int*)(F.lds + MISC_OFF) + 20;
        for (;;) {
            if (F.tid == 0) *itl = (int)__hip_atomic_fetch_add(F.ctl + CW_Q + 64 * l, 1u, __ATOMIC_RELAXED, __HIP_MEMORY_SCOPE_AGENT);
            __syncthreads();
            const int it = *itl;
            if (it >= nitems) break;
            const int row0 = it * CT;
            int g0, g1; if (row0 < RL) { g0 = row0 & ~(GRIDW - 1); g1 = g0 + GRIDW; } else { g0 = RL + ((row0 - RL) & ~(CTXL - 1)); g1 = g0 + CTXL; }
            constexpr int CCH = 8, NTK = CT + CONVK - 1, NCH = (NTK + CCH - 1) / CCH;
            unsigned cva[CCH], cga[CCH], cvb[CCH], cgb[CCH];
#define CV_LOAD(cv_, cg_, c_) do { _Pragma("unroll") for (int q = 0; q < CCH; ++q) { const int ti = (c_) * CCH + q; if (ti < NTK) { const int tok = row0 - (CONVK / 2) + ti; const int tc = (tok >= g0 && tok < g1) ? tok : row0; \
                cv_[q] = *(const unsigned*)(F.P + (size_t)tc * DIN + 2048 + 2 * cp); cg_[q] = *(const unsigned*)(F.P + (size_t)tc * DIN + 3072 + 2 * cp); } } } while (0)
#define CV_USE(cv_, cg_, c_) do { _Pragma("unroll") for (int q = 0; q < CCH; ++q) { const int ti = (c_) * CCH + q; if (ti < NTK) { const int tok = row0 - (CONVK / 2) + ti; const bool ok = (tok >= g0 && tok < g1); \
                f32x2 u; u.x = ok ? bflo(cv_[q]) * sigm(bflo(cg_[q])) : 0.f; u.y = ok ? bfhi(cv_[q]) * sigm(bfhi(cg_[q])) : 0.f; \
                _Pragma("unroll") for (int k = 0; k < CONVK; ++k) { const int to = ti - k; if (to >= 0 && to < CT) acc[to] += w[k] * u; } } } } while (0)
            f32x2 acc[CT];
#pragma unroll
            for (int j = 0; j < CT; ++j) acc[j] = bb;
            CV_LOAD(cva, cga, 0);
#pragma unroll
            for (int c = 0; c < NCH; c += 2) {
                if (c + 1 < NCH) CV_LOAD(cvb, cgb, c + 1);
                CV_USE(cva, cga, c);
                if (c + 2 < NCH) CV_LOAD(cva, cga, c + 2);
                if (c + 1 < NCH) CV_USE(cvb, cgb, c + 1);
            }
#undef CV_LOAD
#undef CV_USE
#pragma unroll
            for (int j = 0; j < CT; ++j) { const float s1 = wave_sum(acc[j].x + acc[j].y), s2 = wave_sum(acc[j].x * acc[j].x + acc[j].y * acc[j].y);
                if (F.lane == 0) red[F.wave * CT + j] = (f32x2){s1, s2}; }
            __syncthreads();
            if (F.tid < CT) { float s1 = 0.f, s2 = 0.f;
#pragma unroll
                for (int wv = 0; wv < NWAVES; ++wv) { const f32x2 r = red[wv * CT + F.tid]; s1 += r.x; s2 += r.y; }
                const float mean = s1 * (1.0f / DCONV), var = fmaxf(s2 * (1.0f / DCONV) - mean * mean, 0.f);
                stat[F.tid] = (f32x2){mean, 1.0f / sqrtf(var + LN_EPS)}; }
            __syncthreads();
#pragma unroll
            for (int j = 0; j < CT; ++j) { const f32x2 st = stat[j];
                const float y0 = (acc[j].x - st.x) * st.y * lng.x + lnb.x, y1 = (acc[j].y - st.x) * st.y * lng.y + lnb.y;
                *(unsigned*)(F.Y + (size_t)(row0 + j) * D + DLRU + 2 * cp) = pk2(y0 * sigm(y0), y1 * sigm(y1)); }
            __syncthreads();
        }
    }
}
__device__ __forceinline__ void rglru_ab(float r, float ig, float xc, float k8, float& a, float& b) {
    a = __builtin_amdgcn_exp2f(k8 * r);
    b = __builtin_amdgcn_sqrtf(fmaxf(__builtin_fmaf(-a, a, 1.0f), 0.f)) * (ig * xc);
}
__device__ __forceinline__ float lam_k8(float lam) { return -8.0f * 1.4426950408889634f * log1pf(expf(-lam)); }
__device__ __forceinline__ void scan1_phase(Frame& F, int l) {
    fresh(F);
    const int cp = F.tid;
    for (int it = blockIdx.x; it < NSUB * 2; it += F.G) {
        const int sc = it >> 1, d = it & 1, r0 = sc * SUBL;
        const f32x2 lm = *(const f32x2*)(F.in[I_LAM] + (size_t)(l * 2 + d) * DLRU + 2 * cp);
        const float k0 = lam_k8(lm.x), k1 = lam_k8(lm.y);
        unsigned rw[SUBL], iw[SUBL], xw[SUBL];
#pragma unroll
        for (int j = 0; j < SUBL; ++j) { const int row = d ? r0 + SUBL - 1 - j : r0 + j;
            rw[j] = *(const unsigned*)(F.GT + (size_t)row * 4096 + (2 * d) * 1024 + 2 * cp); iw[j] = *(const unsigned*)(F.GT + (size_t)row * 4096 + (2 * d + 1) * 1024 + 2 * cp); xw[j] = *(const unsigned*)(F.XC + (size_t)row * DLRU + 2 * cp); }
        float A0 = 1.f, A1 = 1.f, B0 = 0.f, B1 = 0.f;
#pragma unroll
        for (int j = 0; j < SUBL; ++j) {
            float a, b; rglru_ab(bflo(rw[j]), bflo(iw[j]), bflo(xw[j]), k0, a, b); A0 *= a; B0 = a * B0 + b;
            rglru_ab(bfhi(rw[j]), bfhi(iw[j]), bfhi(xw[j]), k1, a, b); A1 *= a; B1 = a * B1 + b; }
        *(f32x2*)(F.SA + (size_t)(sc * 2 + d) * DLRU + 2 * cp) = (f32x2){A0, A1};
        *(f32x2*)(F.SB + (size_t)(sc * 2 + d) * DLRU + 2 * cp) = (f32x2){B0, B1};
    }
}
__device__ __forceinline__ void scan2_phase(Frame& F) {
    fresh(F);
    if (blockIdx.x < 64 && F.tid < 64) {
        const int gt = blockIdx.x * 64 + F.tid, c = gt & 1023, d = (gt >> 10) & 1, b = gt >> 11;
        const float* __restrict__ SA = F.SA; const float* __restrict__ SB = F.SB; float* __restrict__ HIN = F.HIN;
        float carry = 0.f;
        constexpr int NCS = CTXL / SUBL, NLS = SEQ / SUBL;
#pragma unroll
        for (int q = 0; q < NCS; ++q) { const int sc = RL / SUBL + NCS * b + (d ? NCS - 1 - q : q); const size_t ix = (size_t)(sc * 2 + d) * DLRU + c; HIN[ix] = carry; carry = SA[ix] * carry + SB[ix]; }
        for (int q0 = 0; q0 < NLS; q0 += 32) { float sa[32], sb[32];
#pragma unroll
            for (int q = 0; q < 32; ++q) { const int sc = NLS * b + (d ? NLS - 1 - (q0 + q) : q0 + q); const size_t ix = (size_t)(sc * 2 + d) * DLRU + c; sa[q] = SA[ix]; sb[q] = SB[ix]; }
#pragma unroll
            for (int q = 0; q < 32; ++q) { const int sc = NLS * b + (d ? NLS - 1 - (q0 + q) : q0 + q); const size_t ix = (size_t)(sc * 2 + d) * DLRU + c; HIN[ix] = carry; carry = sa[q] * carry + sb[q]; } }
    }
}
__device__ __forceinline__ float gelu_tanh(float x) { return x * sigm(1.5957691216057308f * (x + 0.044715f * x * x * x)); }
__device__ __forceinline__ void scan3_phase(Frame& F, int l) {
    fresh(F);
    const int cp = F.tid;
    const f32x2 lm0 = *(const f32x2*)(F.in[I_LAM] + (size_t)(l * 2 + 0) * DLRU + 2 * cp), lm1 = *(const f32x2*)(F.in[I_LAM] + (size_t)(l * 2 + 1) * DLRU + 2 * cp);
    const float kf0 = lam_k8(lm0.x), kf1 = lam_k8(lm0.y), kb0 = lam_k8(lm1.x), kb1 = lam_k8(lm1.y);
    for (int sc = blockIdx.x; sc < ((l == DEPTH - 1) ? RL / SUBL : NSUB); sc += F.G) {
        const int r0 = sc * SUBL;
        unsigned rw[SUBL], iw[SUBL], xw[SUBL], gw_[SUBL];
#pragma unroll
        for (int j = 0; j < SUBL; ++j) { const int row = r0 + j;
            rw[j] = *(const unsigned*)(F.GT + (size_t)row * 4096 + 0 * 1024 + 2 * cp); iw[j] = *(const unsigned*)(F.GT + (size_t)row * 4096 + 1 * 1024 + 2 * cp); xw[j] = *(const unsigned*)(F.XC + (size_t)row * DLRU + 2 * cp); }
        f32x2 h = *(const f32x2*)(F.HIN + (size_t)(sc * 2 + 0) * DLRU + 2 * cp);
        LAS f32x2* hfl = (LAS f32x2*)(F.lds + RING_OFF) + cp;
#pragma unroll
        for (int j = 0; j < SUBL; ++j) {
            float a, b; rglru_ab(bflo(rw[j]), bflo(iw[j]), bflo(xw[j]), kf0, a, b); h.x = a * h.x + b;
            rglru_ab(bfhi(rw[j]), bfhi(iw[j]), bfhi(xw[j]), kf1, a, b); h.y = a * h.y + b; hfl[j * (NWAVES * 64)] = h; }
        asm volatile("" ::: "memory");
#pragma unroll
        for (int j = 0; j < SUBL; ++j) { const int row = r0 + j;
            rw[j] = *(const unsigned*)(F.GT + (size_t)row * 4096 + 2 * 1024 + 2 * cp); iw[j] = *(const unsigned*)(F.GT + (size_t)row * 4096 + 3 * 1024 + 2 * cp); gw_[j] = *(const unsigned*)(F.P + (size_t)row * DIN + 1024 + 2 * cp); }
        h = *(const f32x2*)(F.HIN + (size_t)(sc * 2 + 1) * DLRU + 2 * cp);
#pragma unroll
        for (int j = SUBL - 1; j >= 0; --j) { const int row = r0 + j;
            float a, b; rglru_ab(bflo(rw[j]), bflo(iw[j]), bflo(xw[j]), kb0, a, b); h.x = a * h.x + b;
            rglru_ab(bfhi(rw[j]), bfhi(iw[j]), bfhi(xw[j]), kb1, a, b); h.y = a * h.y + b;
            const f32x2 hf = hfl[j * (NWAVES * 64)];
            *(unsigned*)(F.Y + (size_t)row * D + 2 * cp) = pk2((hf.x + h.x) * gelu_tanh(bflo(gw_[j])), (hf.y + h.y) * gelu_tanh(bfhi(gw_[j]))); }
    }
}

struct Args { const float* in[N_IN]; float* out; unsigned char* ws; int ph_lo, ph_hi; };
static_assert(sizeof(Args) == N_IN * 8 + 8 + 8 + 8, "Args has no padding");
__global__ void __launch_bounds__(NWAVES * 64, 2) mk_fwd(Args args) {
    extern __shared__ __attribute__((aligned(16))) unsigned char lds[];
    Frame F;
    F.lds = (LAS unsigned char*)lds;
    F.tid = threadIdx.x; F.lane = F.tid & 63; F.wave = __builtin_amdgcn_readfirstlane(F.tid >> 6); F.G = gridDim.x;
#pragma unroll
    for (int i = 0; i < N_IN; ++i) F.in[i] = args.in[i];
    F.out = args.out;
    unsigned char* ws = args.ws;
    gu32* ctl = (gu32*)(ws + WS_CTL); F.ctl = ctl;
    F.MOD = (float*)(ws + WS_MOD); F.SA = (float*)(ws + WS_SA); F.SB = (float*)(ws + WS_SB); F.HIN = (float*)(ws + WS_HIN);
    F.W1T = (bf16*)(ws + WS_W1T); F.W2T = (bf16*)(ws + WS_W2T); F.WINT = (bf16*)(ws + WS_WINT); F.WOUTT = (bf16*)(ws + WS_WOUTT); F.WGT = (bf16*)(ws + WS_WGT);
    F.XS = (_Float16*)(ws + WS_XS); F.A = (bf16*)(ws + WS_A); F.Fb = (bf16*)(ws + WS_F); F.P = (bf16*)(ws + WS_F); F.HID = (bf16*)(ws + WS_HID);
    F.GT = (bf16*)(ws + WS_HID); F.XC = (bf16*)(ws + WS_HID + 132 * MiB); F.Y = (bf16*)(ws + WS_Y); F.SLAB = (float*)(ws + WS_SLAB); F.PSLAB = (float*)(ws + WS_PSLAB);
    for (int u = F.tid; u < (LDS_BYTES - LDSCTL_OFF) / 4; u += NWAVES * 64) ((LAS unsigned*)(F.lds + LDSCTL_OFF))[u] = 0u;
    __syncthreads();
    const int lo = args.ph_lo, hi = args.ph_hi;
    XcdBarrier bar; bar.bar = (unsigned*)(ctl + CW_BAR); bar.x = 0; bar.st = nullptr;
    if (hi - lo > 1) bar = xcd_barrier_post((unsigned*)(ctl + CW_BAR), (volatile LAS unsigned*)(F.lds + MISC_OFF) + 8);
#define PH(k) (lo <= (k) && (k) < hi)
#ifndef DUP_MASK
#define DUP_MASK 0
#endif
#define NREP(j) (1 + ((DUP_MASK >> (j)) & 1))
#ifndef DUP_BAR
#define DUP_BAR 0
#endif
#define SEAM(k) do { if ((k) + 1 < hi) { xcd_barrier(bar); if (DUP_BAR) xcd_barrier(bar); } } while (0)

    if (PH(0)) for (int rep_ = 0; rep_ < NREP(14); ++rep_) { prologue_a(F); SEAM(0); }
    if (PH(1)) { init_phase(F); SEAM(1); }
#pragma unroll 1
    for (int l = 0; l < DEPTH; ++l) {
        const int pb = 2 + 14 * l;
        if (PH(pb + 0)) for (int rep_ = 0; rep_ < NREP(0); ++rep_) {
            pg8::Gemm g{F.A, F.W1T + (size_t)(l * 2 + 0) * NFF * D, R, NFF, D, D, D, 0, 0}; pg8::StaticOrder S; S.init(R, NFF, F.G, (int)blockIdx.x);
            pg8::EpiSwiGLU E{F.HID, DFF};
            pg8::gemm_phase<pg8::EpiSwiGLU, pg8::StaticOrder, true, true>(F.lds + RING_OFF, g, S, E);
            if (rep_ == 0) { if (l + 1 < DEPTH) convert_in_tail(F, l + 1, 0, CV_S1, (R / 256) * (NFF / 256)); if (l > 0) convert_in_tail(F, l, CV_S2, CV_LAYER_ITEMS, (R / 256) * (NFF / 256)); }
            SEAM(pb + 0);
        }
        if (PH(pb + 1)) for (int rep_ = 0; rep_ < NREP(1); ++rep_) {
            { pg8::Gemm g{F.HID, F.W2T + (size_t)(l * 2 + 0) * D * DFF, RL, D, DFF, DFF, DFF, 0, 0}; pg8::StaticOrder S; S.init(RL, D, F.G, (int)blockIdx.x);
              pg8::EpiBf16P E{F.Fb, D};
              pg8::gemm_phase<pg8::EpiBf16P, pg8::StaticOrder, true, true>(F.lds + RING_OFF, g, S, E); }
            { int kc = DFF / KS_FFN; asm volatile("" : "+s"(kc));
              pg8::Gemm g{F.HID, F.W2T + (size_t)(l * 2 + 0) * D * DFF, R, D, kc, DFF, DFF, 2 * (DFF / KS_FFN), 2 * (DFF / KS_FFN)}; pg8::SplitKOrder S{RL / 256, RC / 256, D / 256, KS_FFN, F.G, (int)blockIdx.x};
              pg8::EpiF32 E{F.SLAB, D, RL / 256, (size_t)RC * D};
              pg8::gemm_phase<pg8::EpiF32, pg8::SplitKOrder, true, true>(F.lds + RING_OFF, g, S, E); }
            SEAM(pb + 1);
        }
        if (PH(pb + 2)) { if (NREP(2) > 1) { ln_phase(F, l, 0, true); xcd_barrier(bar); } ln_phase(F, l, 0); SEAM(pb + 2); }
        if (PH(pb + 3)) for (int rep_ = 0; rep_ < NREP(3); ++rep_) {
            { pg8::Gemm g{F.A, F.WINT + (size_t)l * DIN * D, RL, DIN, D, D, D, 0, 0}; pg8::StaticOrder S; S.init(RL, DIN, F.G, (int)blockIdx.x);
              pg8::EpiBf16P E{F.P, DIN};
              pg8::gemm_phase<pg8::EpiBf16P, pg8::StaticOrder, true, true>(F.lds + RING_OFF, g, S, E); }
            { int kc = D / KS_MIX; asm volatile("" : "+s"(kc));
              pg8::Gemm g{F.A, F.WINT + (size_t)l * DIN * D, R, DIN, kc, D, D, 2 * (D / KS_MIX), 2 * (D / KS_MIX)}; pg8::SplitKOrder S{RL / 256, RC / 256, (l == DEPTH - 1) ? DLRU / 256 : DIN / 256, KS_MIX, F.G, (int)blockIdx.x};
              pg8::EpiF32 E{F.PSLAB, DIN, RL / 256, (size_t)RC * DIN};
              pg8::gemm_phase<pg8::EpiF32, pg8::SplitKOrder, true, true>(F.lds + RING_OFF, g, S, E); }
            SEAM(pb + 3);
        }
        if (PH(pb + 4)) for (int rep_ = 0; rep_ < NREP(4); ++rep_) { conv4_phase(F, l); SEAM(pb + 4); }
        if (PH(pb + 5)) for (int rep_ = 0; rep_ < NREP(5); ++rep_) {
            int kg = 256; asm volatile("" : "+s"(kg));
            pg8::Gemm g{F.XC, F.WGT + (size_t)l * 4096 * 256, R, 4096, kg, DLRU, 256, 512, 0}; pg8::StaticOrder S; S.init(R, 4096, F.G, (int)blockIdx.x, 2);
            pg8::EpiGates E{F.GT, F.in[I_BRG] + (size_t)l * 2 * DLRU, F.in[I_BIG] + (size_t)l * 2 * DLRU};
            pg8::gemm_phase<pg8::EpiGates, pg8::StaticOrder, true, true>(F.lds + RING_OFF, g, S, E);
            SEAM(pb + 5);
        }
        if (PH(pb + 6)) for (int rep_ = 0; rep_ < NREP(6); ++rep_) { scan1_phase(F, l); SEAM(pb + 6); }
        if (PH(pb + 7)) for (int rep_ = 0; rep_ < NREP(7); ++rep_) { scan2_phase(F); conv31_phase(F, l); SEAM(pb + 7); }
        if (PH(pb + 8)) for (int rep_ = 0; rep_ < NREP(8); ++rep_) { scan3_phase(F, l); SEAM(pb + 8); }
        if (PH(pb + 9)) for (int rep_ = 0; rep_ < NREP(9); ++rep_) {
            { pg8::Gemm g{F.Y, F.WOUTT + (size_t)l * D * D, RL, D, D, D, D, 0, 0}; pg8::StaticOrder S; S.init(RL, D, F.G, (int)blockIdx.x);
              pg8::EpiBf16P E{F.Fb, D};
              pg8::gemm_phase<pg8::EpiBf16P, pg8::StaticOrder, true, true>(F.lds + RING_OFF, g, S, E); }
            if (l != DEPTH - 1) { int kc = D / KS_WOUT; asm volatile("" : "+s"(kc));
              pg8::Gemm g{F.Y, F.WOUTT + (size_t)l * D * D, R, D, kc, D, D, 2 * (D / KS_WOUT), 2 * (D / KS_WOUT)}; pg8::SplitKOrder S{RL / 256, RC / 256, D / 256, KS_WOUT, F.G, (int)blockIdx.x};
              pg8::EpiF32 E{F.SLAB, D, RL / 256, (size_t)RC * D};
              pg8::gemm_phase<pg8::EpiF32, pg8::SplitKOrder, true, true>(F.lds + RING_OFF, g, S, E); }
            SEAM(pb + 9);
        }
        if (PH(pb + 10)) { if (NREP(10) > 1) { ln_phase(F, l, 1, true); xcd_barrier(bar); } ln_phase(F, l, 1); SEAM(pb + 10); }
        if (PH(pb + 11)) for (int rep_ = 0; rep_ < NREP(11); ++rep_) {
            const int mrows = (l == DEPTH - 1) ? RL : R;
            pg8::Gemm g{F.A, F.W1T + (size_t)(l * 2 + 1) * NFF * D, mrows, NFF, D, D, D, 0, 0}; pg8::StaticOrder S; S.init(mrows, NFF, F.G, (int)blockIdx.x);
            pg8::EpiSwiGLU E{F.HID, DFF};
            pg8::gemm_phase<pg8::EpiSwiGLU, pg8::StaticOrder, true, true>(F.lds + RING_OFF, g, S, E);
            if (l + 1 < DEPTH && rep_ == 0) convert_in_tail(F, l + 1, CV_S1, CV_S2, (mrows / 256) * (NFF / 256));
            SEAM(pb + 11);
        }
        if (PH(pb + 12)) for (int rep_ = 0; rep_ < NREP(12); ++rep_) {
            { pg8::Gemm g{F.HID, F.W2T + (size_t)(l * 2 + 1) * D * DFF, RL, D, DFF, DFF, DFF, 0, 0}; pg8::StaticOrder S; S.init(RL, D, F.G, (int)blockIdx.x);
              pg8::EpiBf16P E{F.Fb, D};
              pg8::gemm_phase<pg8::EpiBf16P, pg8::StaticOrder, true, true>(F.lds + RING_OFF, g, S, E); }
            if (l != DEPTH - 1) { int kc = DFF / KS_FFN; asm volatile("" : "+s"(kc));
              pg8::Gemm g{F.HID, F.W2T + (size_t)(l * 2 + 1) * D * DFF, R, D, kc, DFF, DFF, 2 * (DFF / KS_FFN), 2 * (DFF / KS_FFN)}; pg8::SplitKOrder S{RL / 256, RC / 256, D / 256, KS_FFN, F.G, (int)blockIdx.x};
              pg8::EpiF32 E{F.SLAB, D, RL / 256, (size_t)RC * D};
              pg8::gemm_phase<pg8::EpiF32, pg8::SplitKOrder, true, true>(F.lds + RING_OFF, g, S, E); }
            SEAM(pb + 12);
        }
        if (PH(pb + 13)) { if (NREP(13) > 1) { ln_phase(F, l, 2, true); xcd_barrier(bar); } ln_phase(F, l, 2); SEAM(pb + 13); }
    }
#if defined(DBG_DUMP)
    if (PH(N_PHASES)) {
        for (size_t i = (size_t)blockIdx.x * (NWAVES * 64) + threadIdx.x; i < (size_t)RL * D; i += (size_t)F.G * NWAVES * 64) {
            float v;
            if (DBG_DUMP == 0) v = (float)F.XS[i]; else if (DBG_DUMP == 1) v = bflo(F.Fb[i]); else if (DBG_DUMP == 2) v = bflo(F.A[i]); else if (DBG_DUMP == 3) v = bflo(F.Y[i]);
            else if (DBG_DUMP == 4) v = bflo(F.HID[i]); else if (DBG_DUMP == 5) v = bflo(F.P[i]); else if (DBG_DUMP == 6) v = bflo(F.GT[i]); else if (DBG_DUMP == 7) v = bflo(F.XC[i % ((size_t)R * DLRU)]);
            else if (DBG_DUMP == 8) v = F.MOD[i % ((size_t)DEPTH * 3 * NADA)]; else v = F.SA[i % ((size_t)3 * 5 * 262144)];
            F.out[i] = v; }
    }
#endif
    if (hi == N_PHASES && blockIdx.x == 0 && F.tid == 0) {
        if (__hip_atomic_load(ctl + CW_BAR + XB_TMO, RLX_AGENT) != 0u) F.out[0] = __builtin_nanf("");
    }
#undef PH
#undef SEAM
}

extern "C" void kernel_launch(void* const* d_in, const int* in_sizes, int n_in, void* d_out, int out_size, void* d_ws, size_t ws_size, hipStream_t stream) {
    static int grid = 0;
    if (grid == 0) {
        if (n_in != N_IN || in_sizes[0] != RL * D || out_size != RL * D || ws_size < WS_END) { fprintf(stderr, "kernel_launch: unexpected shapes (n_in %d, in0 %d, out %d, ws %zu); nothing launched\n", n_in, n_in > 0 ? in_sizes[0] : -1, out_size, ws_size); grid = -1; return; }
        int dev = 0, cus = 0, per_cu = 0;
        if (hipGetDevice(&dev) != hipSuccess || hipDeviceGetAttribute(&cus, hipDeviceAttributeMultiprocessorCount, dev) != hipSuccess) { fprintf(stderr, "kernel_launch: device query failed\n"); grid = -1; return; }
        if (hipFuncSetAttribute((const void*)mk_fwd, hipFuncAttributeMaxDynamicSharedMemorySize, LDS_BYTES) != hipSuccess) { fprintf(stderr, "kernel_launch: hipFuncSetAttribute failed\n"); grid = -1; return; }
        if (hipOccupancyMaxActiveBlocksPerMultiprocessor(&per_cu, (const void*)mk_fwd, NWAVES * 64, LDS_BYTES) != hipSuccess || per_cu < 1) fprintf(stderr, "kernel_launch: note: occupancy query reports %d workgroups per CU\n", per_cu);
        (void)hipGetLastError();
        grid = cus;
    }
    if (grid < 0) return;
    if (hipMemsetAsync((char*)d_ws + WS_CTL, 0, CTL_ZERO_BYTES, stream) != hipSuccess) { fprintf(stderr, "kernel_launch: memset failed\n"); return; }
    Args a{};
    for (int i = 0; i < N_IN; ++i) a.in[i] = (const float*)d_in[i];
    a.out = (float*)d_out; a.ws = (unsigned char*)d_ws;
#if defined(DBG_DUMP)
    for (int p = 0; p < DBG_STOP; ++p) { a.ph_lo = p; a.ph_hi = p + 1; hipLaunchKernelGGL(mk_fwd, dim3(grid), dim3(NWAVES * 64), LDS_BYTES, stream, a); }
    a.ph_lo = N_PHASES; a.ph_hi = N_PHASES + 1; hipLaunchKernelGGL(mk_fwd, dim3(grid), dim3(NWAVES * 64), LDS_BYTES, stream, a);
#elif MK_PER_PHASE
    for (int p = 0; p < N_PHASES; ++p) { a.ph_lo = p; a.ph_hi = p + 1; hipLaunchKernelGGL(mk_fwd, dim3(grid), dim3(NWAVES * 64), LDS_BYTES, stream, a); }
#else
    a.ph_lo = 0; a.ph_hi = N_PHASES;
    hipLaunchKernelGGL(mk_fwd, dim3(grid), dim3(NWAVES * 64), LDS_BYTES, stream, a);
#endif
    const hipError_t le = hipPeekAtLastError();
    if (le != hipSuccess) fprintf(stderr, "kernel_launch: launch failed: %s\n", hipGetErrorName(le));
}
```

```cpp
#include <hip/hip_runtime.h>
#include <cstdio>
#include <cstdint>
namespace pg8 {
#define PG8_LAS __attribute__((address_space(3)))
typedef unsigned short bf16_t;
typedef short bf16x8 __attribute__((ext_vector_type(8)));
typedef float f32x4 __attribute__((ext_vector_type(4)));
typedef float f32x2 __attribute__((ext_vector_type(2)));
typedef unsigned u32x4 __attribute__((ext_vector_type(4)));
typedef unsigned u32x2 __attribute__((ext_vector_type(2)));
constexpr int BM = 256, BK = 64, HALF = 128, HTB = HALF * BK * 2  , STAGE_BYTES = 8 * HTB, NXCD = 8, WGM = 8;

__host__ __device__ __forceinline__ int lds_byte(int r, int c) { const int st = (r >> 4) * 2 + (c >> 5), rr = r & 15, cc = c & 31, ob = rr * 64 + cc * 2; return st * 1024 + (ob ^ (((ob >> 9) & 1) << 5)); }
__host__ __device__ __forceinline__ void stage_rc(int b, int& R, int& C) { const int st = b / 1024, sb = b % 1024, swz = sb ^ (((sb >> 9) & 1) << 5); R = (st >> 1) * 16 + swz / 64; C = (st & 1) * 32 + (swz % 64) / 2; }
__host__ __device__ __forceinline__ int perm32(int rho) { const int n = rho >> 4, i = rho & 15; return 8 * (i >> 2) + 4 * n + (i & 3); }

struct Unit { int pm, pn, ks; };
struct Gemm { const bf16_t* A; const bf16_t* Bt; int M, N, K, lda, ldb, ksA, ksB; };

struct StaticOrder {
    int nM, nN, nwg, G, c, ks_shift;
    __host__ __device__ void init(int M, int N, int G_, int c_, int ks_shift_ = 31) { nM = M / BM; nN = N / BM; nwg = nM * nN; G = G_; c = c_; ks_shift = ks_shift_; }
    __host__ __device__ bool next(int i, Unit& u) const {
        const long L = (long)i * G + c; if (L >= nwg) return false;
        int wgid = (int)L; { const int q = nwg / NXCD, r = nwg % NXCD, xcd = wgid % NXCD, off = wgid / NXCD; wgid = (xcd < r ? xcd * (q + 1) : r * (q + 1) + (xcd - r) * q) + off; }
        const int nig = WGM * nN, gid = wgid / nig, fm = gid * WGM, gsz = (nM - fm) < WGM ? (nM - fm) : WGM;
        u.pm = fm + ((wgid % nig) % gsz); u.pn = (wgid % nig) / gsz; u.ks = u.pn >> ks_shift; return true;
    }
    __device__ __forceinline__ void a_ready(const Unit&) const {}
    __device__ __forceinline__ void done(const Unit&) const {}
};

struct SplitKOrder {
    int pm0, nP, nN, KS, G, c;
    __device__ __forceinline__ bool next(int i, Unit& u) const { const int L = i * G + c; if (L >= nP * nN * KS) return false; u.ks = L % KS; const int t = L / KS; u.pn = t % nN; u.pm = pm0 + t / nN; return true; }
    __device__ __forceinline__ void a_ready(const Unit&) const {}
    __device__ __forceinline__ void done(const Unit&) const {}
};

typedef __bf16 bf16x2_t __attribute__((ext_vector_type(2)));
__device__ __forceinline__ unsigned cvt_pk_bf16(float lo, float hi) { f32x2 v = {lo, hi}; bf16x2_t b = __builtin_convertvector(v, bf16x2_t); return __builtin_bit_cast(unsigned, b); }
__device__ __forceinline__ float fast_sigmoid(float x) { return __builtin_amdgcn_rcpf(1.0f + __builtin_amdgcn_exp2f(-1.4426950408889634f * x)); }

struct EpiF32 {
    static constexpr bool PERM = false, AFTER_DRAIN = false;
    float* C0; int ldc, pm0; size_t ks_stride;
    __device__ __forceinline__ void operator()(const f32x4 (&acc)[2][2][4][2], const Unit& u, int wr, int wc, int fr, int fq) const {
        float* C = C0 + (size_t)u.ks * ks_stride;
        const int row0 = (u.pm - pm0) * BM + wr * 64 + fr, col0 = u.pn * BM + wc * 32 + 4 * fq;
#pragma unroll
        for (int ai = 0; ai < 2; ++ai)
#pragma unroll
            for (int m = 0; m < 4; ++m) { float* rowp = C + (size_t)(row0 + ai * HALF + m * 16) * ldc + col0;
#pragma unroll
                for (int bj = 0; bj < 2; ++bj)
#pragma unroll
                    for (int n = 0; n < 2; ++n) *(f32x4*)(rowp + bj * HALF + n * 16) = acc[ai][bj][m][n]; }
    }
};
struct EpiBf16P {
    static constexpr bool PERM = true, AFTER_DRAIN = false;
    bf16_t* O; int ldc;
    __device__ __forceinline__ void operator()(const f32x4 (&acc)[2][2][4][2], const Unit& u, int wr, int wc, int fr, int fq) const {
        const int row0 = u.pm * BM + wr * 64 + fr, col0 = u.pn * BM + wc * 32 + 8 * fq;
#pragma unroll
        for (int ai = 0; ai < 2; ++ai)
#pragma unroll
            for (int m = 0; m < 4; ++m) { bf16_t* rowp = O + (size_t)(row0 + ai * HALF + m * 16) * ldc + col0;
#pragma unroll
                for (int bj = 0; bj < 2; ++bj) { const f32x4 v0 = acc[ai][bj][m][0], v1 = acc[ai][bj][m][1];
                    u32x4 w; w.x = cvt_pk_bf16(v0[0], v0[1]); w.y = cvt_pk_bf16(v0[2], v0[3]); w.z = cvt_pk_bf16(v1[0], v1[1]); w.w = cvt_pk_bf16(v1[2], v1[3]);
                    *(u32x4*)(rowp + bj * HALF) = w; } }
    }
};
struct EpiSwiGLU {
    static constexpr bool PERM = true, AFTER_DRAIN = false;
    bf16_t* O; int ldo;
    __device__ __forceinline__ void operator()(const f32x4 (&acc)[2][2][4][2], const Unit& u, int wr, int wc, int fr, int fq) const {
        const int row0 = u.pm * BM + wr * 64 + fr, col0 = u.pn * HALF + wc * 32 + 8 * fq;
#pragma unroll
        for (int ai = 0; ai < 2; ++ai)
#pragma unroll
            for (int m = 0; m < 4; ++m) { bf16_t* rowp = O + (size_t)(row0 + ai * HALF + m * 16) * ldo + col0;
                float h[8];
#pragma unroll
                for (int n = 0; n < 2; ++n)
#pragma unroll
                    for (int e = 0; e < 4; ++e) { const float gt = acc[ai][0][m][n][e], up = acc[ai][1][m][n][e]; h[4 * n + e] = gt * up * fast_sigmoid(gt); }
                u32x4 w; w.x = cvt_pk_bf16(h[0], h[1]); w.y = cvt_pk_bf16(h[2], h[3]); w.z = cvt_pk_bf16(h[4], h[5]); w.w = cvt_pk_bf16(h[6], h[7]);
                *(u32x4*)rowp = w; }
    }
};
struct EpiGates {
    static constexpr bool PERM = true, AFTER_DRAIN = false;
    bf16_t* G; const float* br; const float* bi;
    __device__ __forceinline__ void operator()(const f32x4 (&acc)[2][2][4][2], const Unit& u, int wr, int wc, int fr, int fq) const {
        const int row0 = u.pm * BM + wr * 64 + fr; const int hh = u.pn >> 2, d = (u.pn >> 1) & 1, half = u.pn & 1;
        const int c0 = 256 * hh + 128 * half + 32 * wc + 8 * fq;
        const f32x4 br0 = *(const f32x4*)(br + d * 1024 + c0), br1 = *(const f32x4*)(br + d * 1024 + c0 + 4), bi0 = *(const f32x4*)(bi + d * 1024 + c0), bi1 = *(const f32x4*)(bi + d * 1024 + c0 + 4);
#pragma unroll
        for (int ai = 0; ai < 2; ++ai)
#pragma unroll
            for (int m = 0; m < 4; ++m) { bf16_t* rowp = G + (size_t)(row0 + ai * HALF + m * 16) * 4096 + (2 * d) * 1024 + c0; float sr[8], si[8];
#pragma unroll
                for (int q = 0; q < 8; ++q) {
                    const float xr = acc[ai][0][m][q >> 2][q & 3] + (q < 4 ? br0[q & 3] : br1[q & 3]), xi = acc[ai][1][m][q >> 2][q & 3] + (q < 4 ? bi0[q & 3] : bi1[q & 3]);
                    const float er = 1.0f + __builtin_amdgcn_exp2f(fminf(-1.4426950408889634f * xr, 60.f)), ei = 1.0f + __builtin_amdgcn_exp2f(fminf(-1.4426950408889634f * xi, 60.f));
                    const float rc = __builtin_amdgcn_rcpf(er * ei); sr[q] = ei * rc; si[q] = er * rc; }
                u32x4 w; w.x = cvt_pk_bf16(sr[0], sr[1]); w.y = cvt_pk_bf16(sr[2], sr[3]); w.z = cvt_pk_bf16(sr[4], sr[5]); w.w = cvt_pk_bf16(sr[6], sr[7]);
                *(u32x4*)rowp = w;
                w.x = cvt_pk_bf16(si[0], si[1]); w.y = cvt_pk_bf16(si[2], si[3]); w.z = cvt_pk_bf16(si[4], si[5]); w.w = cvt_pk_bf16(si[6], si[7]);
                *(u32x4*)(rowp + 1024) = w;
                if (m & 1) asm volatile("" ::: "memory"); }
    }
};

template <class Epi, class Sched, bool ALIGN_EPI = false, bool SP2 = false>
__device__ __forceinline__ void gemm_phase(PG8_LAS unsigned char* lds, const Gemm g, const Sched& S, const Epi& E) {
    int tid_ = threadIdx.x; asm volatile("" : "+v"(tid_));
    const int tid = tid_, wid = __builtin_amdgcn_readfirstlane(tid >> 6), lane = tid & 63, wr = wid >> 2, wc = wid & 3, fr = lane & 15, fq = lane >> 4;
    const int K = g.K, nt = K / BK;
    unsigned voffA[2], voffB[2];
#pragma unroll
    for (int i = 0; i < 2; ++i) { int R, C; stage_rc(tid * 16 + i * 8192, R, C); const int Rb = Epi::PERM ? ((R & ~31) + perm32(R & 31)) : R;
        voffA[i] = (unsigned)(R * g.lda + C) * 2u; voffB[i] = (unsigned)(Rb * g.ldb + C) * 2u; }
    const size_t kstep = (size_t)(BK * 2);
    const size_t hsA = (size_t)HALF * g.lda * 2, hsB = (size_t)HALF * g.ldb * 2;
    const size_t tsA = 2 * hsA, tsB = 2 * hsB;
    const unsigned ldsw = (unsigned)wid * 1024u;
    const int aoff = lds_byte(wr * 64 + fr, fq * 8), boff = lds_byte(wc * 32 + fr, fq * 8);
#define PG8_SA(b, h) (((b) * 2 + (h)) * HTB)
#define PG8_SB(b, h) ((4 + (b) * 2 + (h)) * HTB)
#define PG8_STAGE(bufoff, gbase, voff) do { _Pragma("unroll") for (int _i = 0; _i < 2; ++_i) \
        __builtin_amdgcn_global_load_lds((const unsigned*)((const char*)(gbase) + (voff)[_i]), (PG8_LAS unsigned*)(lds + (bufoff) + ldsw + _i * 8192), 16, 0, 0); } while (0)
#define PG8_LDA(dst, b, h) do { _Pragma("unroll") for (int m = 0; m < 4; ++m) _Pragma("unroll") for (int k = 0; k < 2; ++k) dst[m][k] = *(const PG8_LAS bf16x8*)(lds + PG8_SA(b, h) + aoff + m * 2048 + k * 1024); } while (0)
#define PG8_LDB(dst, b, h) do { _Pragma("unroll") for (int n = 0; n < 2; ++n) _Pragma("unroll") for (int k = 0; k < 2; ++k) dst[n][k] = *(const PG8_LAS bf16x8*)(lds + PG8_SB(b, h) + boff + n * 2048 + k * 1024); } while (0)
#define PG8_MMA(ai, bj, At, Bt) do { __builtin_amdgcn_s_setprio(1); _Pragma("unroll") for (int m = 0; m < 4; ++m) _Pragma("unroll") for (int n = 0; n < 2; ++n) _Pragma("unroll") for (int k = 0; k < 2; ++k) \
        acc[ai][bj][m][n] = __builtin_amdgcn_mfma_f32_16x16x32_bf16(Bt[n][k], At[m][k], acc[ai][bj][m][n], 0, 0, 0); __builtin_amdgcn_s_setprio(0); } while (0)
#define PG8_WAIT_V(n) asm volatile("s_waitcnt vmcnt(" #n ")" ::: "memory")
#define PG8_WAIT_L(n) asm volatile("s_waitcnt lgkmcnt(" #n ")" ::: "memory")
#define PG8_BAR __builtin_amdgcn_s_barrier()
#define PG8_SCHED __builtin_amdgcn_sched_barrier(0)
    Unit cur, nxt; int ui = 0;
    if (!S.next(0, cur)) return;
    f32x4 acc[2][2][4][2];
#pragma unroll
    for (int a = 0; a < 2; ++a)
#pragma unroll
        for (int b = 0; b < 2; ++b)
#pragma unroll
            for (int m = 0; m < 4; ++m)
#pragma unroll
                for (int n = 0; n < 2; ++n) acc[a][b][m][n] = (f32x4){0.f, 0.f, 0.f, 0.f};
    bf16x8 At[4][2], B0[2][2], B1[2][2];
    const char* cA = (const char*)g.A + (size_t)cur.pm * tsA + (size_t)cur.ks * g.ksA; const char* cB = (const char*)g.Bt + (size_t)cur.pn * tsB + (size_t)cur.ks * g.ksB;
    S.a_ready(cur);
    if constexpr (SP2) {
        PG8_STAGE(PG8_SB(0, 0), cB, voffB); PG8_STAGE(PG8_SB(0, 1), cB + hsB, voffB); PG8_STAGE(PG8_SA(0, 0), cA, voffA); PG8_STAGE(PG8_SA(0, 1), cA + hsA, voffA);
        if (wr == 1) PG8_BAR;
        PG8_WAIT_V(2); PG8_BAR;
        PG8_STAGE(PG8_SB(1, 0), cB + kstep, voffB); PG8_STAGE(PG8_SA(1, 0), cA + kstep, voffA); PG8_STAGE(PG8_SB(1, 1), cB + hsB + kstep, voffB);
        PG8_WAIT_V(6); PG8_BAR;
    } else {
        PG8_STAGE(PG8_SB(0, 0), cB, voffB); PG8_STAGE(PG8_SA(0, 0), cA, voffA); PG8_STAGE(PG8_SB(0, 1), cB + hsB, voffB); PG8_STAGE(PG8_SA(0, 1), cA + hsA, voffA);
        if (wr == 1) PG8_BAR;
        PG8_WAIT_V(4); PG8_BAR;
        PG8_STAGE(PG8_SB(1, 0), cB + kstep, voffB); PG8_STAGE(PG8_SA(1, 0), cA + kstep, voffA); PG8_STAGE(PG8_SB(1, 1), cB + hsB + kstep, voffB);
        PG8_WAIT_V(6); PG8_BAR;
    }
    for (;;) {
        const bool has_next = S.next(ui + 1, nxt);
        const char* nA = has_next ? (const char*)g.A + (size_t)nxt.pm * tsA + (size_t)nxt.ks * g.ksA : cA; const char* nB = has_next ? (const char*)g.Bt + (size_t)nxt.pn * tsB + (size_t)nxt.ks * g.ksB : cB;
        for (int t = 0; t < nt; t += 2) {
            const bool last = (t == nt - 2);
            const char* a1 = cA + (size_t)(t + 1) * kstep;
            const char* a2 = last ? nA : cA + (size_t)(t + 2) * kstep; const char* b2 = last ? nB : cB + (size_t)(t + 2) * kstep;
            const char* a3 = a2 + kstep; const char* b3 = b2 + kstep;
            if (last && has_next) S.a_ready(nxt);
            if constexpr (SP2) {
            PG8_LDB(B0, 0, 0); PG8_LDB(B1, 0, 1); PG8_SCHED; PG8_LDA(At, 0, 0); PG8_STAGE(PG8_SA(1, 1), a1 + hsA, voffA);
            PG8_WAIT_V(8); PG8_WAIT_L(0); PG8_BAR; PG8_MMA(0, 0, At, B0); PG8_MMA(0, 1, At, B1); PG8_BAR; PG8_SCHED;
            PG8_LDA(At, 0, 1); PG8_STAGE(PG8_SB(0, 0), b2, voffB); PG8_STAGE(PG8_SB(0, 1), b2 + hsB, voffB); PG8_STAGE(PG8_SA(0, 0), a2, voffA);
            PG8_WAIT_V(8); PG8_WAIT_L(0); PG8_BAR; PG8_MMA(1, 0, At, B0); PG8_MMA(1, 1, At, B1); PG8_BAR; PG8_SCHED;
            PG8_LDB(B0, 1, 0); PG8_LDB(B1, 1, 1); PG8_SCHED; PG8_LDA(At, 1, 0); PG8_STAGE(PG8_SA(0, 1), a2 + hsA, voffA);
            PG8_WAIT_V(8); PG8_WAIT_L(0); PG8_BAR; PG8_MMA(0, 0, At, B0); PG8_MMA(0, 1, At, B1); PG8_BAR; PG8_SCHED;
            PG8_LDA(At, 1, 1); PG8_STAGE(PG8_SB(1, 0), b3, voffB); PG8_STAGE(PG8_SB(1, 1), b3 + hsB, voffB); PG8_STAGE(PG8_SA(1, 0), a3, voffA);
            PG8_WAIT_V(8); PG8_WAIT_L(0); PG8_BAR; PG8_MMA(1, 0, At, B0); PG8_MMA(1, 1, At, B1); PG8_BAR; PG8_SCHED;
            } else {
            PG8_LDB(B0, 0, 0); PG8_SCHED; PG8_LDA(At, 0, 0); PG8_STAGE(PG8_SA(1, 1), a1 + hsA, voffA);
            PG8_WAIT_L(8); PG8_BAR; PG8_WAIT_L(0); PG8_MMA(0, 0, At, B0); PG8_BAR; PG8_SCHED;
            PG8_LDB(B1, 0, 1); PG8_STAGE(PG8_SB(0, 0), b2, voffB);
            PG8_BAR; PG8_WAIT_L(0); PG8_MMA(0, 1, At, B1); PG8_BAR;
            PG8_LDA(At, 0, 1); PG8_STAGE(PG8_SA(0, 0), a2, voffA);
            PG8_BAR; PG8_WAIT_L(0); PG8_MMA(1, 0, At, B0); PG8_BAR; PG8_SCHED;
            PG8_STAGE(PG8_SB(0, 1), b2 + hsB, voffB);
            PG8_WAIT_V(6); PG8_BAR; PG8_MMA(1, 1, At, B1); PG8_BAR;
            PG8_LDB(B0, 1, 0); PG8_SCHED; PG8_LDA(At, 1, 0); PG8_STAGE(PG8_SA(0, 1), a2 + hsA, voffA);
            PG8_WAIT_L(8); PG8_BAR; PG8_WAIT_L(0); PG8_MMA(0, 0, At, B0); PG8_BAR; PG8_SCHED;
            PG8_LDB(B1, 1, 1); PG8_STAGE(PG8_SB(1, 0), b3, voffB);
            PG8_BAR; PG8_WAIT_L(0); PG8_MMA(0, 1, At, B1); PG8_BAR;
            PG8_LDA(At, 1, 1); PG8_STAGE(PG8_SA(1, 0), a3, voffA);
            PG8_BAR; PG8_WAIT_L(0); PG8_MMA(1, 0, At, B0); PG8_BAR; PG8_SCHED;
            PG8_STAGE(PG8_SB(1, 1), b3 + hsB, voffB);
            PG8_WAIT_V(6); PG8_BAR; PG8_MMA(1, 1, At, B1); PG8_BAR;
            }
        }
        if constexpr (ALIGN_EPI) { if (wr == 0) PG8_BAR; }
        if constexpr (!Epi::AFTER_DRAIN) { E(acc, cur, wr, wc, fr, fq); S.done(cur); }
        if (!has_next) break;
#pragma unroll
        for (int a = 0; a < 2; ++a)
#pragma unroll
            for (int b = 0; b < 2; ++b)
#pragma unroll
                for (int m = 0; m < 4; ++m)
#pragma unroll
                    for (int n = 0; n < 2; ++n) acc[a][b][m][n] = (f32x4){0.f, 0.f, 0.f, 0.f};
        cur = nxt; cA = nA; cB = nB; ++ui;
        if constexpr (ALIGN_EPI) { if (wr == 1) PG8_BAR; }
    }
    PG8_WAIT_V(0);
    if constexpr (!ALIGN_EPI) { if (wr == 0) PG8_BAR; }
    PG8_BAR;
    if constexpr (Epi::AFTER_DRAIN) { E.fused(acc, cur, wr, wc, fr, fq, lds, wid, lane); S.done(cur); }
#undef PG8_SA
#undef PG8_SB
#undef PG8_STAGE
#undef PG8_LDA
#undef PG8_LDB
#undef PG8_MMA
#undef PG8_WAIT_V
#undef PG8_WAIT_L
#undef PG8_BAR
#undef PG8_SCHED
}
}

constexpr int NWAVES = 8;
constexpr int D = 2048, BATCH = 2, SEQ = 8192, CTXL = 256, DEPTH = 2;
constexpr int RL = BATCH * SEQ, RC = BATCH * CTXL, R = RL + RC;
constexpr int DFF = 5632, NFF = 2 * DFF, DLRU = 1024, DCONV = 1024, DIN = 4096, NMOD = 9, NADA = NMOD * D;
constexpr int CONVK = 31, GRIDW = 64;
constexpr float LN_EPS = 1e-6f, ALPHA = 1.41421356237309515f;
constexpr int SUBL = 32, NSUB = R / SUBL;
#ifndef MK_PER_PHASE
#define MK_PER_PHASE 0
#endif
constexpr int N_PHASES = 2 + 14 * DEPTH;
constexpr int KS_FFN = 11, KS_WOUT = 8, KS_MIX = 8;

enum { I_X = 0, I_C, I_CTX, I_CCTX, I_WADA, I_BADA, I_LNG, I_LNB, I_FF1IN, I_FF1OUT, I_FF2IN, I_FF2OUT, I_WIN, I_C4W, I_C4B, I_WRG, I_BRG, I_WIG, I_BIG, I_LAM, I_C31W, I_C31B, I_CLNG, I_CLNB, I_WOUT, I_BOUT, N_IN };

constexpr size_t MiB = 1u << 20;
constexpr size_t WS_CTL = 0, CTL_ZERO_BYTES = 1 * MiB;
constexpr size_t WS_MOD = 1 * MiB;
constexpr size_t WS_SA = 2 * MiB, WS_SB = 7 * MiB, WS_HIN = 12 * MiB;
constexpr size_t WS_W1T = 17 * MiB;
constexpr size_t WS_W2T = 193 * MiB;
constexpr size_t WS_WINT = 281 * MiB;
constexpr size_t WS_WOUTT = 313 * MiB;
constexpr size_t WS_WGT = 329 * MiB;
constexpr size_t WS_XS = 333 * MiB;
constexpr size_t WS_A = 465 * MiB;
constexpr size_t WS_F = 531 * MiB;
constexpr size_t WS_HID = 663 * MiB;
constexpr size_t WS_Y = 845 * MiB;
constexpr size_t WS_SLAB = 911 * MiB;
constexpr size_t WS_PSLAB = 955 * MiB;
constexpr size_t WS_END = 1019 * MiB;
static_assert(WS_W1T + (size_t)4 * NFF * D * 2 <= WS_W2T && WS_W2T + (size_t)4 * D * DFF * 2 <= WS_WINT && WS_WINT + (size_t)2 * DIN * D * 2 <= WS_WOUTT && WS_WOUTT + (size_t)2 * D * D * 2 <= WS_WGT && WS_WGT + (size_t)2 * 4096 * 256 * 2 <= WS_XS, "ws map (weights)");
static_assert(WS_XS + (size_t)R * D * 4 <= WS_A && WS_A + (size_t)R * D * 2 <= WS_F && WS_F + (size_t)R * D * 4 <= WS_HID && WS_HID + (size_t)R * DFF * 2 <= WS_Y && WS_Y + (size_t)R * D * 2 <= WS_SLAB && WS_SLAB + (size_t)11 * RC * D * 4 <= WS_PSLAB && WS_PSLAB + (size_t)8 * RC * DIN * 4 <= WS_END, "ws map (activations)");
static_assert((size_t)R * DIN * 2 <= (size_t)R * D * 4 && (size_t)R * 4096 * 2 + (size_t)R * 1024 * 2 <= (size_t)R * DFF * 2 && (size_t)NSUB * 2 * 1024 * 4 <= 5 * MiB, "ws overlays");
constexpr int CW_TMO = 0, CW_CODE = 1, CW_BAR = 4096, CW_Q = 8192;

constexpr int RING_OFF = 0, RING_BYTES = 131072;
constexpr int LDSCTL_OFF = RING_BYTES, MISC_OFF = LDSCTL_OFF + 320;
constexpr int LDS_BYTES = 147456;

#define GAS __attribute__((address_space(1)))
#define LAS __attribute__((address_space(3)))
typedef unsigned short bf16;
typedef unsigned v4u __attribute__((ext_vector_type(4)));
typedef unsigned v2u __attribute__((ext_vector_type(2)));
typedef float f32x4 __attribute__((ext_vector_type(4)));
typedef float f32x2 __attribute__((ext_vector_type(2)));
typedef GAS unsigned gu32;
typedef _Float16 f16x4 __attribute__((ext_vector_type(4)));
#define RLX_AGENT __ATOMIC_RELAXED, __HIP_MEMORY_SCOPE_AGENT
#define LDS_WAIT() asm volatile("s_waitcnt lgkmcnt(0)" ::: "memory")
#define VM_WAIT() asm volatile("s_waitcnt vmcnt(0)" ::: "memory")
__device__ __forceinline__ unsigned f2bf(float f) { unsigned u = __builtin_bit_cast(unsigned, f); return (u + 0x7fffu + ((u >> 16) & 1u)) >> 16; }
__device__ __forceinline__ unsigned pk2(float lo, float hi) { return pg8::cvt_pk_bf16(lo, hi); }
__device__ __forceinline__ float bflo(unsigned u) { return __uint_as_float(u << 16); }
__device__ __forceinline__ float bfhi(unsigned u) { return __uint_as_float(u & 0xffff0000u); }
__device__ __forceinline__ float sigm(float x) { return __builtin_amdgcn_rcpf(1.0f + __builtin_amdgcn_exp2f(-1.4426950408889634f * x)); }
template <int CTRL> __device__ __forceinline__ float dpp_mov(float v) { return __builtin_bit_cast(float, __builtin_amdgcn_update_dpp(0, __builtin_bit_cast(int, v), CTRL, 0xf, 0xf, true)); }
__device__ __forceinline__ float wave_sum(float v) {
    v += dpp_mov<0xB1>(v); v += dpp_mov<0x4E>(v); v += dpp_mov<0x141>(v); v += dpp_mov<0x140>(v);
    { auto r = __builtin_amdgcn_permlane16_swap(__float_as_uint(v), __float_as_uint(v), false, false); v = __uint_as_float(r[0]) + __uint_as_float(r[1]); }
    { auto r = __builtin_amdgcn_permlane32_swap(__float_as_uint(v), __float_as_uint(v), false, false); v = __uint_as_float(r[0]) + __uint_as_float(r[1]); }
    return v;
}

#define XB_TMO      128
#define XB_XCNT(j)  (256  + 64 * (j))
#define XB_XSUB(j)  (1280 + 64 * (j))
#define XB_XGEN(j)  (2304 + 64 * (j))
#define XB_TOP      3328
#define XB_TOPGEN   3392
#define XCD_BAR_WORDS 3456
#define XB_SPIN_CAP (1u << 18)

__device__ __forceinline__ unsigned xb_ld(unsigned* p)              { return __hip_atomic_load(p, __ATOMIC_RELAXED, __HIP_MEMORY_SCOPE_AGENT); }
__device__ __forceinline__ unsigned xb_add(unsigned* p, unsigned v) { return __hip_atomic_fetch_add(p, v, __ATOMIC_RELAXED, __HIP_MEMORY_SCOPE_AGENT); }
__device__ __forceinline__ unsigned xb_xcc_id() { return (unsigned)__builtin_amdgcn_s_getreg((3 << 11) | 20) & 0xFu; }
#define XB_SPIN(cond, bar) do { unsigned _sp = 0; while (cond) { __builtin_amdgcn_s_sleep(1); \
    if ((++_sp & 255u) == 0u) { if (xb_ld(&(bar)[XB_TMO])) break; if (_sp > XB_SPIN_CAP) { atomicAdd(&(bar)[XB_TMO], 1u); break; } } } } while (0)

struct XcdBarrier {
    unsigned* bar; unsigned x;
    volatile LAS unsigned* st;
};
__device__ __forceinline__ XcdBarrier xcd_barrier_post(unsigned* bar, volatile LAS unsigned* st) {
    XcdBarrier b; b.bar = bar; b.x = xb_xcc_id(); b.st = st;
    if (threadIdx.x == 0) (void)xb_add(&bar[XB_XCNT(b.x)], 1u);
    return b;
}
__device__ __forceinline__ void xcd_barrier_complete(unsigned* bar, unsigned x, unsigned& nloc, unsigned& nx) {
    const unsigned G = gridDim.x * gridDim.y * gridDim.z;
    unsigned sum, cnt, mine, sp = 0u;
    for (;;) {
        sum = 0u; cnt = 0u; mine = 0u;
#pragma unroll
        for (unsigned j = 0; j < 16; ++j) { const unsigned c = xb_ld(&bar[XB_XCNT(j)]); sum += c; cnt += (c > 0u) ? 1u : 0u; mine = (j == x) ? c : mine; }
        if (sum == G) break;
        __builtin_amdgcn_s_sleep(1);
        if ((++sp & 255u) == 0u) { if (xb_ld(&bar[XB_TMO])) break; if (sp > XB_SPIN_CAP) { atomicAdd(&bar[XB_TMO], 1u); break; } }
    }
    nloc = mine > 0u ? mine : 1u; nx = cnt > 0u ? cnt : 1u;
}
__device__ __forceinline__ void xcd_barrier(const XcdBarrier& b) {
    asm volatile("s_waitcnt vmcnt(0)" ::: "memory");
    __syncthreads();
    if (threadIdx.x == 0) {
        unsigned* bar = b.bar;
        __builtin_amdgcn_s_waitcnt(0);
        unsigned nloc = b.st[0], nx = b.st[1];
        if (nloc == 0u) { xcd_barrier_complete(bar, b.x, nloc, nx); b.st[0] = nloc; b.st[1] = nx; }
        const unsigned old = xb_add(&bar[XB_XSUB(b.x)], 1u);
        const unsigned gen = old / nloc;
        if (old + 1u == (gen + 1u) * nloc) {
            __builtin_amdgcn_fence(__ATOMIC_RELEASE, "agent");
            asm volatile("s_waitcnt vmcnt(0)" ::: "memory");
            const unsigned og = xb_add(&bar[XB_TOP], 1u);
            const unsigned tg = og / nx;
            if (og + 1u == (tg + 1u) * nx) xb_add(&bar[XB_TOPGEN], 1u);
            else XB_SPIN(xb_ld(&bar[XB_TOPGEN]) == tg, bar);
            __builtin_amdgcn_fence(__ATOMIC_ACQUIRE, "agent");
            xb_add(&bar[XB_XGEN(b.x)], 1u);
            asm volatile("s_waitcnt vmcnt(0)" ::: "memory");
        } else {
            XB_SPIN(xb_ld(&bar[XB_XGEN(b.x)]) == gen, bar);
            __builtin_amdgcn_fence(__ATOMIC_ACQUIRE, "agent");
            asm volatile("s_waitcnt vmcnt(0)" ::: "memory");
        }
    }
    __syncthreads();
}

struct Frame {
    LAS unsigned char* lds;
    gu32* ctl;
    int tid, lane, wave, G;
    const float* in[N_IN]; float* out;
    float* MOD; float *SA, *SB, *HIN;
    bf16 *W1T, *W2T, *WINT, *WOUTT, *WGT;
    _Float16* XS; bf16* A; bf16* Fb; bf16* P; bf16* HID; bf16* GT; bf16* XC; bf16* Y; float* SLAB; float* PSLAB;
};

__device__ __forceinline__ void fresh(Frame& F) { int t = threadIdx.x; asm volatile("" : "+v"(t)); F.tid = t; F.lane = t & 63; F.wave = __builtin_amdgcn_readfirstlane(t >> 6); }
__device__ __forceinline__ void transpose_item(const float* W, int ldw, int src_col, bf16* WT, int ldk, int dst_row, int k0, LAS float* scr, int lane) {
    const int c4 = (lane & 7) * 4, kr = lane >> 3; f32x4 v[8];
#pragma unroll
    for (int i = 0; i < 8; ++i) v[i] = *(const f32x4*)(W + (size_t)(k0 + 8 * i + kr) * ldw + src_col + c4);
#pragma unroll
    for (int i = 0; i < 8; ++i) { LAS float* d = scr + (8 * i + kr) * 33 + c4; d[0] = v[i][0]; d[1] = v[i][1]; d[2] = v[i][2]; d[3] = v[i][3]; }
    LDS_WAIT(); asm volatile("" ::: "memory");
    const int c = lane & 7;
#pragma unroll
    for (int j = 0; j < 4; ++j) { const int n = (lane >> 3) + 8 * j; const LAS float* s = scr + (8 * c) * 33 + n;
        v4u o; o.x = pk2(s[0 * 33], s[1 * 33]); o.y = pk2(s[2 * 33], s[3 * 33]); o.z = pk2(s[4 * 33], s[5 * 33]); o.w = pk2(s[6 * 33], s[7 * 33]);
        *(v4u*)(WT + (size_t)(dst_row + n) * ldk + k0 + 8 * c) = o; }
    LDS_WAIT(); asm volatile("" ::: "memory");
}
constexpr int IT_FIN = (D / 64) * (NFF / 32), IT_FOUT = (DFF / 64) * (D / 32), IT_WIN = (D / 64) * (DIN / 32), IT_WOUT = (D / 64) * (D / 32), IT_G = (256 / 64) * (4096 / 32);
constexpr int CV_LAYER_ITEMS = 2 * IT_FIN + 2 * IT_FOUT + IT_WIN + IT_WOUT + IT_G;
#ifndef CV_TAIL_PCT
#define CV_TAIL_PCT 100
#endif
constexpr int CV_TAIL_ITEMS = (int)((long)CV_LAYER_ITEMS * CV_TAIL_PCT / 100);
__device__ __forceinline__ void convert_layer_items(Frame& F, int l, int it_begin, int it_end, int widx, int nw) {
    LAS float* scr = (LAS float*)(F.lds + RING_OFF + F.wave * 16384);
    for (int it = it_begin + widx; it < it_end; it += nw) {
        int r = it;
#define CV_FIN(f) { const int kb = r / (NFF / 32), nb = r % (NFF / 32), dst_row = 32 * nb, pn = dst_row >> 8, lc = dst_row & 255, src_col = lc < 128 ? 128 * pn + lc : DFF + 128 * pn + (lc - 128); \
            transpose_item(F.in[(f) ? I_FF2IN : I_FF1IN] + (size_t)l * D * NFF, NFF, src_col, F.W1T + (size_t)(l * 2 + (f)) * NFF * D, D, dst_row, 64 * kb, scr, F.lane); continue; }
#define CV_FOUT(f) { const int kb = r / (D / 32), nb = r % (D / 32); \
            transpose_item(F.in[(f) ? I_FF2OUT : I_FF1OUT] + (size_t)l * DFF * D, D, 32 * nb, F.W2T + (size_t)(l * 2 + (f)) * D * DFF, DFF, 32 * nb, 64 * kb, scr, F.lane); continue; }
        if (r < IT_FIN) CV_FIN(0)
        r -= IT_FIN;
        if (r < IT_FOUT) CV_FOUT(0)
        r -= IT_FOUT;
        if (r < IT_WIN) { const int kb = r / (DIN / 32), nb = r % (DIN / 32);
            transpose_item(F.in[I_WIN] + (size_t)l * D * DIN, DIN, 32 * nb, F.WINT + (size_t)l * DIN * D, D, 32 * nb, 64 * kb, scr, F.lane); continue; }
        r -= IT_WIN;
        if (r < IT_G) { const int kb = r / 128, nb = r % 128; const int dst_row = 32 * nb, pn = dst_row >> 8, lc = dst_row & 255, hh = pn >> 2, d = (pn >> 1) & 1, half = pn & 1;
            const float* src = F.in[lc < 128 ? I_WRG : I_WIG] + (size_t)((l * 2 + d) * 4 + hh) * 65536;
            transpose_item(src, 256, 128 * half + (lc & 127), F.WGT + (size_t)l * 4096 * 256, 256, dst_row, 64 * kb, scr, F.lane); continue; }
        r -= IT_G;
        if (r < IT_WOUT) { const int kb = r / (D / 32), nb = r % (D / 32);
            transpose_item(F.in[I_WOUT] + (size_t)l * D * D, D, 32 * nb, F.WOUTT + (size_t)l * D * D, D, 32 * nb, 64 * kb, scr, F.lane); continue; }
        r -= IT_WOUT;
        if (r < IT_FIN) CV_FIN(1)
        r -= IT_FIN;
        CV_FOUT(1)
#undef CV_FIN
#undef CV_FOUT
    }
}
__device__ __forceinline__ void convert_in_tail(Frame& F, int lconv, int it_begin, int it_end, int nunits) {
    fresh(F);
    const int first = nunits % F.G, nwg = F.G - first;
    if ((int)blockIdx.x < first) return;
    convert_layer_items(F, lconv, it_begin, it_end, ((int)blockIdx.x - first) * NWAVES + F.wave, nwg * NWAVES);
}
constexpr int CV_S2 = IT_FIN + IT_FOUT + IT_WIN + IT_G + IT_WOUT, CV_S1 = CV_S2 / 2;
__device__ __forceinline__ void prologue_a(Frame& F) {
    fresh(F);
    {
        LAS float* sv = (LAS float*)(F.lds + RING_OFF);
        LAS float* red = (LAS float*)(F.lds + RING_OFF + 32768);
#pragma unroll
        for (int i = F.tid; i < 3 * D; i += NWAVES * 64) { const int v = i >> 11, k = i & (D - 1); const float cv = v < 2 ? F.in[I_C][v * D + k] : F.in[I_CCTX][k]; sv[i] = cv * sigm(cv); }
        __syncthreads();
        const int cg = F.lane & 15, rg = F.lane >> 4;
#ifndef DUP_ADA
#define DUP_ADA 0
#endif
        for (int rep2 = 0; rep2 <= DUP_ADA; ++rep2)
        for (int it = blockIdx.x; it < DEPTH * (NADA / 64); it += F.G) {
            const int l = it / (NADA / 64), n0 = (it % (NADA / 64)) * 64;
            const float* W = F.in[I_WADA] + (size_t)l * D * NADA + n0 + 4 * cg;
            f32x4 a0 = {0.f, 0.f, 0.f, 0.f}, a1 = a0, a2 = a0;
#pragma unroll 8
            for (int kk = 0; kk < 64; ++kk) { const int k = F.wave * 256 + kk * 4 + rg; const f32x4 w = *(const f32x4*)(W + (size_t)k * NADA);
                a0 += w * sv[k]; a1 += w * sv[D + k]; a2 += w * sv[2 * D + k]; }
#pragma unroll
            for (int e = 0; e < 4; ++e) { a0[e] += __shfl_xor(a0[e], 16); a0[e] += __shfl_xor(a0[e], 32); a1[e] += __shfl_xor(a1[e], 16); a1[e] += __shfl_xor(a1[e], 32); a2[e] += __shfl_xor(a2[e], 16); a2[e] += __shfl_xor(a2[e], 32); }
            if (rg == 0) {
#pragma unroll
                for (int e = 0; e < 4; ++e) { red[(F.wave * 3 + 0) * 64 + 4 * cg + e] = a0[e]; red[(F.wave * 3 + 1) * 64 + 4 * cg + e] = a1[e]; red[(F.wave * 3 + 2) * 64 + 4 * cg + e] = a2[e]; }
            }
            __syncthreads();
            if (F.tid < 192) { const int v = F.tid >> 6, n = F.tid & 63; float s = F.in[I_BADA][(size_t)l * NADA + n0 + n];
#pragma unroll
                for (int w = 0; w < 8; ++w) s += red[(w * 3 + v) * 64 + n];
                F.MOD[((size_t)l * 3 + v) * NADA + n0 + n] = s; }
            __syncthreads();
        }
    }
    convert_layer_items(F, 0, 0, CV_LAYER_ITEMS, blockIdx.x * NWAVES + F.wave, F.G * NWAVES);
}
__device__ __forceinline__ void init_phase(Frame& F) {
    fresh(F);
    const int gw = blockIdx.x * NWAVES + F.wave, NGW = F.G * NWAVES;
    for (int row0 = gw; row0 < R; row0 += 2 * NGW) {
        f32x4 xv[2][8];
#pragma unroll
        for (int h = 0; h < 2; ++h) { const int row = row0 + h * NGW; if (row < R) { const float* src = row < RL ? F.in[I_X] + (size_t)row * D : F.in[I_CTX] + (size_t)(row - RL) * D;
#pragma unroll
            for (int j = 0; j < 8; ++j) xv[h][j] = *(const f32x4*)(src + 8 * F.lane + 512 * (j >> 1) + 4 * (j & 1)); } }
#pragma unroll
        for (int h = 0; h < 2; ++h) { const int row = row0 + h * NGW; if (row < R) { const float* m = F.MOD + (size_t)(row < RL ? (row >> 13) : 2) * NADA;
#pragma unroll
            for (int q = 0; q < 4; ++q) { const int col = 8 * F.lane + 512 * q;
                const f32x4 a0 = xv[h][2 * q] * (1.0f + *(const f32x4*)(m + D + col)) + *(const f32x4*)(m + col), a1 = xv[h][2 * q + 1] * (1.0f + *(const f32x4*)(m + D + col + 4)) + *(const f32x4*)(m + col + 4);
                v4u o; o.x = pk2(a0[0], a0[1]); o.y = pk2(a0[2], a0[3]); o.z = pk2(a1[0], a1[1]); o.w = pk2(a1[2], a1[3]);
                *(v4u*)(F.A + (size_t)row * D + col) = o; } } }
    }
}
#define LN_COL(lane, j) (8 * (lane) + 512 * ((j) >> 1) + 4 * ((j) & 1))
typedef _Float16 f16x8 __attribute__((ext_vector_type(8)));
__device__ __forceinline__ void ln_load(const float* xin, const _Float16* xh, const bf16* fb, const float* fs, int nks, int lane, f32x4 (&x)[8], f32x4 (&f)[8]) {
    if (xin) {
#pragma unroll
        for (int j = 0; j < 8; ++j) x[j] = *(const f32x4*)(xin + LN_COL(lane, j));
    } else {
#pragma unroll
        for (int q = 0; q < 4; ++q) { const f16x8 h = *(const f16x8*)(xh + LN_COL(lane, 2 * q));
            x[2 * q] = (f32x4){(float)h[0], (float)h[1], (float)h[2], (float)h[3]}; x[2 * q + 1] = (f32x4){(float)h[4], (float)h[5], (float)h[6], (float)h[7]}; }
    }
    if (nks == 0) {
#pragma unroll
        for (int q = 0; q < 4; ++q) { const v4u w = *(const v4u*)(fb + LN_COL(lane, 2 * q));
            f[2 * q] = (f32x4){bflo(w.x), bfhi(w.x), bflo(w.y), bfhi(w.y)}; f[2 * q + 1] = (f32x4){bflo(w.z), bfhi(w.z), bflo(w.w), bfhi(w.w)}; }
    } else {
#pragma unroll
        for (int j = 0; j < 8; ++j) f[j] = *(const f32x4*)(fs + LN_COL(lane, j));
        for (int ks = 1; ks < nks; ++ks) {
#pragma unroll
            for (int j = 0; j < 8; ++j) f[j] += *(const f32x4*)(fs + (size_t)ks * RC * D + LN_COL(lane, j)); }
    }
}
__device__ __forceinline__ void ln_finish(f32x4 (&x)[8], const f32x4 (&f)[8], const LAS float* Tv, const LAS float* Tg, int lane, float* xo, _Float16* xho, bf16* ao) {
    float sum = 0.f;
#pragma unroll
    for (int j = 0; j < 8; ++j) { const int col = LN_COL(lane, j); const f32x4 gg = *(const LAS f32x4*)(Tv + col), bb = *(const LAS f32x4*)(Tv + D + col);
        x[j] = ALPHA * x[j] + (gg * f[j] + bb); sum += (x[j][0] + x[j][1]) + (x[j][2] + x[j][3]); if (j & 1) asm volatile("" ::: "memory"); }
    const float mean = wave_sum(sum) * (1.0f / D); float s2 = 0.f;
#pragma unroll
    for (int j = 0; j < 8; ++j) { x[j] = x[j] - mean; s2 += (x[j][0] * x[j][0] + x[j][1] * x[j][1]) + (x[j][2] * x[j][2] + x[j][3] * x[j][3]); }
    const float rstd = 1.0f / sqrtf(wave_sum(s2) * (1.0f / D) + LN_EPS);
#pragma unroll
    for (int q = 0; q < 4; ++q) { const int col = LN_COL(lane, 2 * q); const f32x4 n0 = x[2 * q] * rstd, n1 = x[2 * q + 1] * rstd;
        const f32x4 y0 = n0 * *(const LAS f32x4*)(Tg + col) + *(const LAS f32x4*)(Tg + D + col), y1 = n1 * *(const LAS f32x4*)(Tg + col + 4) + *(const LAS f32x4*)(Tg + D + col + 4);
        if (xo) { *(f32x4*)(xo + col) = y0; *(f32x4*)(xo + col + 4) = y1; }
        else *(f16x8*)(xho + col) = (f16x8){(_Float16)y0[0], (_Float16)y0[1], (_Float16)y0[2], (_Float16)y0[3], (_Float16)y1[0], (_Float16)y1[1], (_Float16)y1[2], (_Float16)y1[3]};
        if (ao) { const f32x4 a0 = n0 * *(const LAS f32x4*)(Tv + 2 * D + col) + *(const LAS f32x4*)(Tv + 3 * D + col), a1 = n1 * *(const LAS f32x4*)(Tv + 2 * D + col + 4) + *(const LAS f32x4*)(Tv + 3 * D + col + 4);
            v4u o; o.x = pk2(a0[0], a0[1]); o.y = pk2(a0[2], a0[3]); o.z = pk2(a1[0], a1[1]); o.w = pk2(a1[2], a1[3]); *(v4u*)(ao + col) = o; }
        asm volatile("" ::: "memory"); }
}
__device__ __forceinline__ void ln_phase(Frame& F, int l, int s, bool dummy = false) {
    fresh(F);
    const bool last = (l == DEPTH - 1 && s == 2), first = (l == 0 && s == 0);
    const float gsc = (s == 1) ? 1.0f : 0.5f;
    const float* bias = (s == 1) ? F.in[I_BOUT] + (size_t)l * D : nullptr;
    const float* lg = F.in[I_LNG] + (size_t)(l * 3 + s) * D; const float* lb = F.in[I_LNB] + (size_t)(l * 3 + s) * D;
    const float* modl = F.MOD + (size_t)l * 3 * NADA;
    const float* modn = (s == 2) ? F.MOD + (size_t)(last ? l : l + 1) * 3 * NADA : modl;
    const int shi = (s == 2) ? 0 : 3 * s + 3;
    const int nrows = last ? RL : R;
    const int nks = (s == 1) ? KS_WOUT : KS_FFN;
    LAS float* T = (LAS float*)(F.lds + RING_OFF);
#pragma unroll
    for (int i = F.tid; i < 3 * D; i += NWAVES * 64) { const int v = i >> 11, col = i & (D - 1);
        const float gg = gsc * modl[(size_t)v * NADA + (3 * s + 2) * D + col], lgv = lg[col], lbv = lb[col];
        const float sh = modn[(size_t)v * NADA + shi * D + col], sc = modn[(size_t)v * NADA + (shi + 1) * D + col];
        T[(v * 4 + 0) * D + col] = gg; T[(v * 4 + 1) * D + col] = bias ? gg * bias[col] : 0.f; T[(v * 4 + 2) * D + col] = lgv * (1.0f + sc); T[(v * 4 + 3) * D + col] = lbv * (1.0f + sc) + sh;
        if (v == 0) { T[12 * D + col] = lgv; T[13 * D + col] = lbv; } }
    __syncthreads();
    const LAS float* Tg = T + 12 * D;
    const int l_begin = (int)((long)RL * blockIdx.x / F.G), l_end = (int)((long)RL * (blockIdx.x + 1) / F.G);
    const int c_begin = (int)((long)RC * blockIdx.x / F.G), nc = (l == DEPTH - 1 && s >= 1) ? 0 : (int)((long)RC * (blockIdx.x + 1) / F.G) - c_begin,     ntot = nc + (l_end - l_begin);
    LAS unsigned* ctr = (LAS unsigned*)(F.lds + MISC_OFF) + 16;
#define LN_GRAB(k_) do { unsigned g_ = 0u; if (F.lane == 0) g_ = __hip_atomic_fetch_add(ctr, 1u, __ATOMIC_RELAXED, __HIP_MEMORY_SCOPE_WORKGROUP); k_ = __builtin_amdgcn_readfirstlane((int)g_); } while (0)
#define LN_ROW(k_) ((k_) < nc ? RL + c_begin + (k_) : l_begin + ((k_) - nc))
#define LN_SRC(row, xin, fin, nk) const float* xin = first ? ((row) < RL ? F.in[I_X] + (size_t)(row) * D : F.in[I_CTX] + (size_t)((row) - RL) * D) : nullptr; const _Float16* xh = F.XS + (size_t)(row) * D; \
        const bf16* fb = F.Fb + (size_t)((row) < RL ? (row) : 0) * D; const float* fin = F.SLAB + (size_t)((row) < RL ? 0 : (row) - RL) * D; const int nk = (row) < RL ? 0 : nks;
#define LN_DST(row, Tv, xo, ao) const LAS float* Tv = T + ((row) < RL ? ((row) >> 13) : 2) * 4 * D; float* xo = last ? (dummy ? (float*)F.HID : F.out) + (size_t)(row) * D : nullptr; _Float16* xho = (dummy ? (_Float16*)F.HID : F.XS) + (size_t)(row) * D; bf16* ao = dummy ? F.Y + (size_t)(row) * D : last ? nullptr : F.A + (size_t)(row) * D;
    {
        f32x4 xa[8], fa[8], xb[8], fb_[8];
        int ka, kb; LN_GRAB(ka);
        if (ka < ntot) { const int rA = LN_ROW(ka); LN_SRC(rA, xin, fin, nk) ln_load(xin, xh, fb, fin, nk, F.lane, xa, fa); }
        while (ka < ntot) {
            LN_GRAB(kb);
            if (kb < ntot) { const int rB = LN_ROW(kb); LN_SRC(rB, xin, fin, nk) ln_load(xin, xh, fb, fin, nk, F.lane, xb, fb_); }
            asm volatile("" ::: "memory");
            { const int rA = LN_ROW(ka); LN_DST(rA, Tv, xo, ao) ln_finish(xa, fa, Tv, Tg, F.lane, xo, xho, ao); }
            asm volatile("" ::: "memory");
            if (kb >= ntot) break;
            LN_GRAB(ka);
            if (ka < ntot) { const int rA = LN_ROW(ka); LN_SRC(rA, xin, fin, nk) ln_load(xin, xh, fb, fin, nk, F.lane, xa, fa); }
            asm volatile("" ::: "memory");
            { const int rB = LN_ROW(kb); LN_DST(rB, Tv, xo, ao) ln_finish(xb, fb_, Tv, Tg, F.lane, xo, xho, ao); }
            asm volatile("" ::: "memory");
        }
    }
#undef LN_GRAB
#undef LN_ROW
#undef LN_SRC
#undef LN_DST
    __syncthreads();
    if (F.tid == 0) *ctr = 0u;
}
constexpr int CT = 16;
__device__ __forceinline__ void conv4_phase(Frame& F, int l) {
    fresh(F);
    {
        const float* w4 = F.in[I_C4W] + (size_t)l * 4 * DLRU; const float* b4 = F.in[I_C4B] + (size_t)l * DLRU;
        for (int idx = blockIdx.x * (NWAVES * 64) + F.tid; idx < R * (DLRU / 8); idx += F.G * NWAVES * 64) {
            const int row = idx >> 7, c8 = (idx & 127) * 8;
            int s0, s1; if (row < RL) { s0 = row & ~(SEQ - 1); s1 = s0 + SEQ; } else { s0 = RL + ((row - RL) & ~(CTXL - 1)); s1 = s0 + CTXL; }
            f32x4 a0 = *(const f32x4*)(b4 + c8), a1 = *(const f32x4*)(b4 + c8 + 4);
#pragma unroll
            for (int k = 0; k < 4; ++k) { const int rr = row + k - 2;
                if (rr >= s0 && rr < s1) { const f32x4 w0 = *(const f32x4*)(w4 + k * DLRU + c8), w1 = *(const f32x4*)(w4 + k * DLRU + c8 + 4); f32x4 x0, x1;
                    if (row < RL) { const v4u xv = *(const v4u*)(F.P + (size_t)rr * DIN + c8); x0 = (f32x4){bflo(xv.x), bfhi(xv.x), bflo(xv.y), bfhi(xv.y)}; x1 = (f32x4){bflo(xv.z), bfhi(xv.z), bflo(xv.w), bfhi(xv.w)}; }
                    else { const float* sp = F.PSLAB + (size_t)(rr - RL) * DIN + c8; x0 = *(const f32x4*)sp; x1 = *(const f32x4*)(sp + 4);
#pragma unroll
                        for (int ks = 1; ks < KS_MIX; ++ks) { x0 += *(const f32x4*)(sp + (size_t)ks * RC * DIN); x1 += *(const f32x4*)(sp + (size_t)ks * RC * DIN + 4); } }
                    a0 += w0 * x0; a1 += w1 * x1; } }
            v4u o; o.x = pk2(a0[0], a0[1]); o.y = pk2(a0[2], a0[3]); o.z = pk2(a1[0], a1[1]); o.w = pk2(a1[2], a1[3]);
            *(v4u*)(F.XC + (size_t)row * DLRU + c8) = o;
        }
    }
    if (l != DEPTH - 1) {
        for (int idx = blockIdx.x * (NWAVES * 64) + F.tid; idx < RC * ((DIN - DLRU) / 8); idx += F.G * NWAVES * 64) {
            const int rc = idx / ((DIN - DLRU) / 8), c8 = DLRU + (idx % ((DIN - DLRU) / 8)) * 8;
            const float* sp = F.PSLAB + (size_t)rc * DIN + c8; f32x4 x0 = *(const f32x4*)sp, x1 = *(const f32x4*)(sp + 4);
#pragma unroll
            for (int ks = 1; ks < KS_MIX; ++ks) { x0 += *(const f32x4*)(sp + (size_t)ks * RC * DIN); x1 += *(const f32x4*)(sp + (size_t)ks * RC * DIN + 4); }
            v4u o; o.x = pk2(x0[0], x0[1]); o.y = pk2(x0[2], x0[3]); o.z = pk2(x1[0], x1[1]); o.w = pk2(x1[2], x1[3]);
            *(v4u*)(F.P + (size_t)(RL + rc) * DIN + c8) = o;
        }
    }
}
__device__ __forceinline__ void conv31_phase(Frame& F, int l) {
    fresh(F);
    {
        const float* w31 = F.in[I_C31W] + (size_t)l * CONVK * DCONV; const float* b31 = F.in[I_C31B] + (size_t)l * DCONV;
        const float* cg_ = F.in[I_CLNG] + (size_t)l * DCONV; const float* cb_ = F.in[I_CLNB] + (size_t)l * DCONV;
        LAS f32x2* red = (LAS f32x2*)(F.lds + RING_OFF);
        LAS f32x2* stat = (LAS f32x2*)(F.lds + RING_OFF + 4096);
        const int cp = F.tid;
        f32x2 w[CONVK];
#pragma unroll
        for (int k = 0; k < CONVK; ++k) w[k] = *(const f32x2*)(w31 + k * DCONV + 2 * cp);
        const f32x2 bb = *(const f32x2*)(b31 + 2 * cp), lng = *(const f32x2*)(cg_ + 2 * cp), lnb = *(const f32x2*)(cb_ + 2 * cp);
        const int nitems = ((l == DEPTH - 1) ? RL : R) / CT;
        LAS int* itl = (LAS int*)(F.lds + MISC_OFF) + 20;
        for (;;) {
            if (F.tid == 0) *itl = (int)__hip_atomic_fetch_add(F.ctl + CW_Q + 64 * l, 1u, __ATOMIC_RELAXED, __HIP_MEMORY_SCOPE_AGENT);
            __syncthreads();
            const int it = *itl;
            if (it >= nitems) break;
            const int row0 = it * CT;
            int g0, g1; if (row0 < RL) { g0 = row0 & ~(GRIDW - 1); g1 = g0 + GRIDW; } else { g0 = RL + ((row0 - RL) & ~(CTXL - 1)); g1 = g0 + CTXL; }
            constexpr int CCH = 8, NTK = CT + CONVK - 1, NCH = (NTK + CCH - 1) / CCH;
            unsigned cva[CCH], cga[CCH], cvb[CCH], cgb[CCH];
#define CV_LOAD(cv_, cg_, c_) do { _Pragma("unroll") for (int q = 0; q < CCH; ++q) { const int ti = (c_) * CCH + q; if (ti < NTK) { const int tok = row0 - (CONVK / 2) + ti; const int tc = (tok >= g0 && tok < g1) ? tok : row0; \
                cv_[q] = *(const unsigned*)(F.P + (size_t)tc * DIN + 2048 + 2 * cp); cg_[q] = *(const unsigned*)(F.P + (size_t)tc * DIN + 3072 + 2 * cp); } } } while (0)
#define CV_USE(cv_, cg_, c_) do { _Pragma("unroll") for (int q = 0; q < CCH; ++q) { const int ti = (c_) * CCH + q; if (ti < NTK) { const int tok = row0 - (CONVK / 2) + ti; const bool ok = (tok >= g0 && tok < g1); \
                f32x2 u; u.x = ok ? bflo(cv_[q]) * sigm(bflo(cg_[q])) : 0.f; u.y = ok ? bfhi(cv_[q]) * sigm(bfhi(cg_[q])) : 0.f; \
                _Pragma("unroll") for (int k = 0; k < CONVK; ++k) { const int to = ti - k; if (to >= 0 && to < CT) acc[to] += w[k] * u; } } } } while (0)
            f32x2 acc[CT];
#pragma unroll
            for (int j = 0; j < CT; ++j) acc[j] = bb;
            CV_LOAD(cva, cga, 0);
#pragma unroll
            for (int c = 0; c < NCH; c += 2) {
                if (c + 1 < NCH) CV_LOAD(cvb, cgb, c + 1);
                CV_USE(cva, cga, c);
                if (c + 2 < NCH) CV_LOAD(cva, cga, c + 2);
                if (c + 1 < NCH) CV_USE(cvb, cgb, c + 1);
            }
#undef CV_LOAD
#undef CV_USE
#pragma unroll
            for (int j = 0; j < CT; ++j) { const float s1 = wave_sum(acc[j].x + acc[j].y), s2 = wave_sum(acc[j].x * acc[j].x + acc[j].y * acc[j].y);
                if (F.lane == 0) red[F.wave * CT + j] = (f32x2){s1, s2}; }
            __syncthreads();
            if (F.tid < CT) { float s1 = 0.f, s2 = 0.f;
#pragma unroll
                for (int wv = 0; wv < NWAVES; ++wv) { const f32x2 r = red[wv * CT + F.tid]; s1 += r.x; s2 += r.y; }
                const float mean = s1 * (1.0f / DCONV), var = fmaxf(s2 * (1.0f / DCONV) - mean * mean, 0.f);
                stat[F.tid] = (f32x2){mean, 1.0f / sqrtf(var + LN_EPS)}; }
            __syncthreads();
#pragma unroll
            for (int j = 0; j < CT; ++j) { const f32x2 st = stat[j];
                const float y0 = (acc[j].x - st.x) * st.y * lng.x + lnb.x, y1 = (acc[j].y - st.x) * st.y * lng.y + lnb.y;
                *(unsigned*)(F.Y + (size_t)(row0 + j) * D + DLRU + 2 * cp) = pk2(y0 * sigm(y0), y1 * sigm(y1)); }
            __syncthreads();
        }
    }
}
__device__ __forceinline__ void rglru_ab(float r, float ig, float xc, float k8, float& a, float& b) {
    a = __builtin_amdgcn_exp2f(k8 * r);
    b = __builtin_amdgcn_sqrtf(fmaxf(__builtin_fmaf(-a, a, 1.0f), 0.f)) * (ig * xc);
}
__device__ __forceinline__ float lam_k8(float lam) { return -8.0f * 1.4426950408889634f * log1pf(expf(-lam)); }
__device__ __forceinline__ void scan1_phase(Frame& F, int l) {
    fresh(F);
    const int cp = F.tid;
    for (int it = blockIdx.x; it < NSUB * 2; it += F.G) {
        const int sc = it >> 1, d = it & 1, r0 = sc * SUBL;
        const f32x2 lm = *(const f32x2*)(F.in[I_LAM] + (size_t)(l * 2 + d) * DLRU + 2 * cp);
        const float k0 = lam_k8(lm.x), k1 = lam_k8(lm.y);
        unsigned rw[SUBL], iw[SUBL], xw[SUBL];
#pragma unroll
        for (int j = 0; j < SUBL; ++j) { const int row = d ? r0 + SUBL - 1 - j : r0 + j;
            rw[j] = *(const unsigned*)(F.GT + (size_t)row * 4096 + (2 * d) * 1024 + 2 * cp); iw[j] = *(const unsigned*)(F.GT + (size_t)row * 4096 + (2 * d + 1) * 1024 + 2 * cp); xw[j] = *(const unsigned*)(F.XC + (size_t)row * DLRU + 2 * cp); }
        float A0 = 1.f, A1 = 1.f, B0 = 0.f, B1 = 0.f;
#pragma unroll
        for (int j = 0; j < SUBL; ++j) {
            float a, b; rglru_ab(bflo(rw[j]), bflo(iw[j]), bflo(xw[j]), k0, a, b); A0 *= a; B0 = a * B0 + b;
            rglru_ab(bfhi(rw[j]), bfhi(iw[j]), bfhi(xw[j]), k1, a, b); A1 *= a; B1 = a * B1 + b; }
        *(f32x2*)(F.SA + (size_t)(sc * 2 + d) * DLRU + 2 * cp) = (f32x2){A0, A1};
        *(f32x2*)(F.SB + (size_t)(sc * 2 + d) * DLRU + 2 * cp) = (f32x2){B0, B1};
    }
}
__device__ __forceinline__ void scan2_phase(Frame& F) {
    fresh(F);
    if (blockIdx.x < 64 && F.tid < 64) {
        const int gt = blockIdx.x * 64 + F.tid, c = gt & 1023, d = (gt >> 10) & 1, b = gt >> 11;
        const float* __restrict__ SA = F.SA; const float* __restrict__ SB = F.SB; float* __restrict__ HIN = F.HIN;
        float carry = 0.f;
        constexpr int NCS = CTXL / SUBL, NLS = SEQ / SUBL;
#pragma unroll
        for (int q = 0; q < NCS; ++q) { const int sc = RL / SUBL + NCS * b + (d ? NCS - 1 - q : q); const size_t ix = (size_t)(sc * 2 + d) * DLRU + c; HIN[ix] = carry; carry = SA[ix] * carry + SB[ix]; }
        for (int q0 = 0; q0 < NLS; q0 += 32) { float sa[32], sb[32];
#pragma unroll
            for (int q = 0; q < 32; ++q) { const int sc = NLS * b + (d ? NLS - 1 - (q0 + q) : q0 + q); const size_t ix = (size_t)(sc * 2 + d) * DLRU + c; sa[q] = SA[ix]; sb[q] = SB[ix]; }
#pragma unroll
            for (int q = 0; q < 32; ++q) { const int sc = NLS * b + (d ? NLS - 1 - (q0 + q) : q0 + q); const size_t ix = (size_t)(sc * 2 + d) * DLRU + c; HIN[ix] = carry; carry = sa[q] * carry + sb[q]; } }
    }
}
__device__ __forceinline__ float gelu_tanh(float x) { return x * sigm(1.5957691216057308f * (x + 0.044715f * x * x * x)); }
__device__ __forceinline__ void scan3_phase(Frame& F, int l) {
    fresh(F);
    const int cp = F.tid;
    const f32x2 lm0 = *(const f32x2*)(F.in[I_LAM] + (size_t)(l * 2 + 0) * DLRU + 2 * cp), lm1 = *(const f32x2*)(F.in[I_LAM] + (size_t)(l * 2 + 1) * DLRU + 2 * cp);
    const float kf0 = lam_k8(lm0.x), kf1 = lam_k8(lm0.y), kb0 = lam_k8(lm1.x), kb1 = lam_k8(lm1.y);
    for (int sc = blockIdx.x; sc < ((l == DEPTH - 1) ? RL / SUBL : NSUB); sc += F.G) {
        const int r0 = sc * SUBL;
        unsigned rw[SUBL], iw[SUBL], xw[SUBL], gw_[SUBL];
#pragma unroll
        for (int j = 0; j < SUBL; ++j) { const int row = r0 + j;
            rw[j] = *(const unsigned*)(F.GT + (size_t)row * 4096 + 0 * 1024 + 2 * cp); iw[j] = *(const unsigned*)(F.GT + (size_t)row * 4096 + 1 * 1024 + 2 * cp); xw[j] = *(const unsigned*)(F.XC + (size_t)row * DLRU + 2 * cp); }
        f32x2 h = *(const f32x2*)(F.HIN + (size_t)(sc * 2 + 0) * DLRU + 2 * cp);
        LAS f32x2* hfl = (LAS f32x2*)(F.lds + RING_OFF) + cp;
#pragma unroll
        for (int j = 0; j < SUBL; ++j) {
            float a, b; rglru_ab(bflo(rw[j]), bflo(iw[j]), bflo(xw[j]), kf0, a, b); h.x = a * h.x + b;
            rglru_ab(bfhi(rw[j]), bfhi(iw[j]), bfhi(xw[j]), kf1, a, b); h.y = a * h.y + b; hfl[j * (NWAVES * 64)] = h; }
        asm volatile("" ::: "memory");
#pragma unroll
        for (int j = 0; j < SUBL; ++j) { const int row = r0 + j;
            rw[j] = *(const unsigned*)(F.GT + (size_t)row * 4096 + 2 * 1024 + 2 * cp); iw[j] = *(const unsigned*)(F.GT + (size_t)row * 4096 + 3 * 1024 + 2 * cp); gw_[j] = *(const unsigned*)(F.P + (size_t)row * DIN + 1024 + 2 * cp); }
        h = *(const f32x2*)(F.HIN + (size_t)(sc * 2 + 1) * DLRU + 2 * cp);
#pragma unroll
        for (int j = SUBL - 1; j >= 0; --j) { const int row = r0 + j;
            float a, b; rglru_ab(bflo(rw[j]), bflo(iw[j]), bflo(xw[j]), kb0, a, b); h.x = a * h.x + b;
            rglru_ab(bfhi(rw[j]), bfhi(iw[j]), bfhi(xw[j]), kb1, a, b); h.y = a * h.y + b;
            const f32x2 hf = hfl[j * (NWAVES * 64)];
            *(unsigned*)(F.Y + (size_t)row * D + 2 * cp) = pk2((hf.x + h.x) * gelu_tanh(bflo(gw_[j])), (hf.y + h.y) * gelu_tanh(bfhi(gw_[j]))); }
    }
}

struct Args { const float* in[N_IN]; float* out; unsigned char* ws; int ph_lo, ph_hi; };
static_assert(sizeof(Args) == N_IN * 8 + 8 + 8 + 8, "Args has no padding");
__global__ void __launch_bounds__(NWAVES * 64, 2) mk_fwd(Args args) {
    extern __shared__ __attribute__((aligned(16))) unsigned char lds[];
    Frame F;
    F.lds = (LAS unsigned char*)lds;
    F.tid = threadIdx.x; F.lane = F.tid & 63; F.wave = __builtin_amdgcn_readfirstlane(F.tid >> 6); F.G = gridDim.x;
#pragma unroll
    for (int i = 0; i < N_IN; ++i) F.in[i] = args.in[i];
    F.out = args.out;
    unsigned char* ws = args.ws;
    gu32* ctl = (gu32*)(ws + WS_CTL); F.ctl = ctl;
    F.MOD = (float*)(ws + WS_MOD); F.SA = (float*)(ws + WS_SA); F.SB = (float*)(ws + WS_SB); F.HIN = (float*)(ws + WS_HIN);
    F.W1T = (bf16*)(ws + WS_W1T); F.W2T = (bf16*)(ws + WS_W2T); F.WINT = (bf16*)(ws + WS_WINT); F.WOUTT = (bf16*)(ws + WS_WOUTT); F.WGT = (bf16*)(ws + WS_WGT);
    F.XS = (_Float16*)(ws + WS_XS); F.A = (bf16*)(ws + WS_A); F.Fb = (bf16*)(ws + WS_F); F.P = (bf16*)(ws + WS_F); F.HID = (bf16*)(ws + WS_HID);
    F.GT = (bf16*)(ws + WS_HID); F.XC = (bf16*)(ws + WS_HID + 132 * MiB); F.Y = (bf16*)(ws + WS_Y); F.SLAB = (float*)(ws + WS_SLAB); F.PSLAB = (float*)(ws + WS_PSLAB);
    for (int u = F.tid; u < (LDS_BYTES - LDSCTL_OFF) / 4; u += NWAVES * 64) ((LAS unsigned*)(F.lds + LDSCTL_OFF))[u] = 0u;
    __syncthreads();
    const int lo = args.ph_lo, hi = args.ph_hi;
    XcdBarrier bar; bar.bar = (unsigned*)(ctl + CW_BAR); bar.x = 0; bar.st = nullptr;
    if (hi - lo > 1) bar = xcd_barrier_post((unsigned*)(ctl + CW_BAR), (volatile LAS unsigned*)(F.lds + MISC_OFF) + 8);
#define PH(k) (lo <= (k) && (k) < hi)
#ifndef DUP_MASK
#define DUP_MASK 0
#endif
#define NREP(j) (1 + ((DUP_MASK >> (j)) & 1))
#ifndef DUP_BAR
#define DUP_BAR 0
#endif
#define SEAM(k) do { if ((k) + 1 < hi) { xcd_barrier(bar); if (DUP_BAR) xcd_barrier(bar); } } while (0)

    if (PH(0)) for (int rep_ = 0; rep_ < NREP(14); ++rep_) { prologue_a(F); SEAM(0); }
    if (PH(1)) { init_phase(F); SEAM(1); }
#pragma unroll 1
    for (int l = 0; l < DEPTH; ++l) {
        const int pb = 2 + 14 * l;
        if (PH(pb + 0)) for (int rep_ = 0; rep_ < NREP(0); ++rep_) {
            pg8::Gemm g{F.A, F.W1T + (size_t)(l * 2 + 0) * NFF * D, R, NFF, D, D, D, 0, 0}; pg8::StaticOrder S; S.init(R, NFF, F.G, (int)blockIdx.x);
            pg8::EpiSwiGLU E{F.HID, DFF};
            pg8::gemm_phase<pg8::EpiSwiGLU, pg8::StaticOrder, true, true>(F.lds + RING_OFF, g, S, E);
            if (rep_ == 0) { if (l + 1 < DEPTH) convert_in_tail(F, l + 1, 0, CV_S1, (R / 256) * (NFF / 256)); if (l > 0) convert_in_tail(F, l, CV_S2, CV_LAYER_ITEMS, (R / 256) * (NFF / 256)); }
            SEAM(pb + 0);
        }
        if (PH(pb + 1)) for (int rep_ = 0; rep_ < NREP(1); ++rep_) {
            { pg8::Gemm g{F.HID, F.W2T + (size_t)(l * 2 + 0) * D * DFF, RL, D, DFF, DFF, DFF, 0, 0}; pg8::StaticOrder S; S.init(RL, D, F.G, (int)blockIdx.x);
              pg8::EpiBf16P E{F.Fb, D};
              pg8::gemm_phase<pg8::EpiBf16P, pg8::StaticOrder, true, true>(F.lds + RING_OFF, g, S, E); }
            { int kc = DFF / KS_FFN; asm volatile("" : "+s"(kc));
              pg8::Gemm g{F.HID, F.W2T + (size_t)(l * 2 + 0) * D * DFF, R, D, kc, DFF, DFF, 2 * (DFF / KS_FFN), 2 * (DFF / KS_FFN)}; pg8::SplitKOrder S{RL / 256, RC / 256, D / 256, KS_FFN, F.G, (int)blockIdx.x};
              pg8::EpiF32 E{F.SLAB, D, RL / 256, (size_t)RC * D};
              pg8::gemm_phase<pg8::EpiF32, pg8::SplitKOrder, true, true>(F.lds + RING_OFF, g, S, E); }
            SEAM(pb + 1);
        }
        if (PH(pb + 2)) { if (NREP(2) > 1) { ln_phase(F, l, 0, true); xcd_barrier(bar); } ln_phase(F, l, 0); SEAM(pb + 2); }
        if (PH(pb + 3)) for (int rep_ = 0; rep_ < NREP(3); ++rep_) {
            { pg8::Gemm g{F.A, F.WINT + (size_t)l * DIN * D, RL, DIN, D, D, D, 0, 0}; pg8::StaticOrder S; S.init(RL, DIN, F.G, (int)blockIdx.x);
              pg8::EpiBf16P E{F.P, DIN};
              pg8::gemm_phase<pg8::EpiBf16P, pg8::StaticOrder, true, true>(F.lds + RING_OFF, g, S, E); }
            { int kc = D / KS_MIX; asm volatile("" : "+s"(kc));
              pg8::Gemm g{F.A, F.WINT + (size_t)l * DIN * D, R, DIN, kc, D, D, 2 * (D / KS_MIX), 2 * (D / KS_MIX)}; pg8::SplitKOrder S{RL / 256, RC / 256, (l == DEPTH - 1) ? DLRU / 256 : DIN / 256, KS_MIX, F.G, (int)blockIdx.x};
              pg8::EpiF32 E{F.PSLAB, DIN, RL / 256, (size_t)RC * DIN};
              pg8::gemm_phase<pg8::EpiF32, pg8::SplitKOrder, true, true>(F.lds + RING_OFF, g, S, E); }
            SEAM(pb + 3);
        }
        if (PH(pb + 4)) for (int rep_ = 0; rep_ < NREP(4); ++rep_) { conv4_phase(F, l); SEAM(pb + 4); }
        if (PH(pb + 5)) for (int rep_ = 0; rep_ < NREP(5); ++rep_) {
            int kg = 256; asm volatile("" : "+s"(kg));
            pg8::Gemm g{F.XC, F.WGT + (size_t)l * 4096 * 256, R, 4096, kg, DLRU, 256, 512, 0}; pg8::StaticOrder S; S.init(R, 4096, F.G, (int)blockIdx.x, 2);
            pg8::EpiGates E{F.GT, F.in[I_BRG] + (size_t)l * 2 * DLRU, F.in[I_BIG] + (size_t)l * 2 * DLRU};
            pg8::gemm_phase<pg8::EpiGates, pg8::StaticOrder, true, true>(F.lds + RING_OFF, g, S, E);
            SEAM(pb + 5);
        }
        if (PH(pb + 6)) for (int rep_ = 0; rep_ < NREP(6); ++rep_) { scan1_phase(F, l); SEAM(pb + 6); }
        if (PH(pb + 7)) for (int rep_ = 0; rep_ < NREP(7); ++rep_) { scan2_phase(F); conv31_phase(F, l); SEAM(pb + 7); }
        if (PH(pb + 8)) for (int rep_ = 0; rep_ < NREP(8); ++rep_) { scan3_phase(F, l); SEAM(pb + 8); }
        if (PH(pb + 9)) for (int rep_ = 0; rep_ < NREP(9); ++rep_) {
            { pg8::Gemm g{F.Y, F.WOUTT + (size_t)l * D * D, RL, D, D, D, D, 0, 0}; pg8::StaticOrder S; S.init(RL, D, F.G, (int)blockIdx.x);
              pg8::EpiBf16P E{F.Fb, D};
              pg8::gemm_phase<pg8::EpiBf16P, pg8::StaticOrder, true, true>(F.lds + RING_OFF, g, S, E); }
            if (l != DEPTH - 1) { int kc = D / KS_WOUT; asm volatile("" : "+s"(kc));
              pg8::Gemm g{F.Y, F.WOUTT + (size_t)l * D * D, R, D, kc, D, D, 2 * (D / KS_WOUT), 2 * (D / KS_WOUT)}; pg8::SplitKOrder S{RL / 256, RC / 256, D / 256, KS_WOUT, F.G, (int)blockIdx.x};
              pg8::EpiF32 E{F.SLAB, D, RL / 256, (size_t)RC * D};
              pg8::gemm_phase<pg8::EpiF32, pg8::SplitKOrder, true, true>(F.lds + RING_OFF, g, S, E); }
            SEAM(pb + 9);
        }
        if (PH(pb + 10)) { if (NREP(10) > 1) { ln_phase(F, l, 1, true); xcd_barrier(bar); } ln_phase(F, l, 1); SEAM(pb + 10); }
        if (PH(pb + 11)) for (int rep_ = 0; rep_ < NREP(11); ++rep_) {
            const int mrows = (l == DEPTH - 1) ? RL : R;
            pg8::Gemm g{F.A, F.W1T + (size_t)(l * 2 + 1) * NFF * D, mrows, NFF, D, D, D, 0, 0}; pg8::StaticOrder S; S.init(mrows, NFF, F.G, (int)blockIdx.x);
            pg8::EpiSwiGLU E{F.HID, DFF};
            pg8::gemm_phase<pg8::EpiSwiGLU, pg8::StaticOrder, true, true>(F.lds + RING_OFF, g, S, E);
            if (l + 1 < DEPTH && rep_ == 0) convert_in_tail(F, l + 1, CV_S1, CV_S2, (mrows / 256) * (NFF / 256));
            SEAM(pb + 11);
        }
        if (PH(pb + 12)) for (int rep_ = 0; rep_ < NREP(12); ++rep_) {
            { pg8::Gemm g{F.HID, F.W2T + (size_t)(l * 2 + 1) * D * DFF, RL, D, DFF, DFF, DFF, 0, 0}; pg8::StaticOrder S; S.init(RL, D, F.G, (int)blockIdx.x);
              pg8::EpiBf16P E{F.Fb, D};
              pg8::gemm_phase<pg8::EpiBf16P, pg8::StaticOrder, true, true>(F.lds + RING_OFF, g, S, E); }
            if (l != DEPTH - 1) { int kc = DFF / KS_FFN; asm volatile("" : "+s"(kc));
              pg8::Gemm g{F.HID, F.W2T + (size_t)(l * 2 + 1) * D * DFF, R, D, kc, DFF, DFF, 2 * (DFF / KS_FFN), 2 * (DFF / KS_FFN)}; pg8::SplitKOrder S{RL / 256, RC / 256, D / 256, KS_FFN, F.G, (int)blockIdx.x};
              pg8::EpiF32 E{F.SLAB, D, RL / 256, (size_t)RC * D};
              pg8::gemm_phase<pg8::EpiF32, pg8::SplitKOrder, true, true>(F.lds + RING_OFF, g, S, E); }
            SEAM(pb + 12);
        }
        if (PH(pb + 13)) { if (NREP(13) > 1) { ln_phase(F, l, 2, true); xcd_barrier(bar); } ln_phase(F, l, 2); SEAM(pb + 13); }
    }
#if defined(DBG_DUMP)
    if (PH(N_PHASES)) {
        for (size_t i = (size_t)blockIdx.x * (NWAVES * 64) + threadIdx.x; i < (size_t)RL * D; i += (size_t)F.G * NWAVES * 64) {
            float v;
            if (DBG_DUMP == 0) v = (float)F.XS[i]; else if (DBG_DUMP == 1) v = bflo(F.Fb[i]); else if (DBG_DUMP == 2) v = bflo(F.A[i]); else if (DBG_DUMP == 3) v = bflo(F.Y[i]);
            else if (DBG_DUMP == 4) v = bflo(F.HID[i]); else if (DBG_DUMP == 5) v = bflo(F.P[i]); else if (DBG_DUMP == 6) v = bflo(F.GT[i]); else if (DBG_DUMP == 7) v = bflo(F.XC[i % ((size_t)R * DLRU)]);
            else if (DBG_DUMP == 8) v = F.MOD[i % ((size_t)DEPTH * 3 * NADA)]; else v = F.SA[i % ((size_t)3 * 5 * 262144)];
            F.out[i] = v; }
    }
#endif
    if (hi == N_PHASES && blockIdx.x == 0 && F.tid == 0) {
        if (__hip_atomic_load(ctl + CW_BAR + XB_TMO, RLX_AGENT) != 0u) F.out[0] = __builtin_nanf("");
    }
#undef PH
#undef SEAM
}

extern "C" void kernel_launch(void* const* d_in, const int* in_sizes, int n_in, void* d_out, int out_size, void* d_ws, size_t ws_size, hipStream_t stream) {
    static int grid = 0;
    if (grid == 0) {
        if (n_in != N_IN || in_sizes[0] != RL * D || out_size != RL * D || ws_size < WS_END) { fprintf(stderr, "kernel_launch: unexpected shapes (n_in %d, in0 %d, out %d, ws %zu); nothing launched\n", n_in, n_in > 0 ? in_sizes[0] : -1, out_size, ws_size); grid = -1; return; }
        int dev = 0, cus = 0, per_cu = 0;
        if (hipGetDevice(&dev) != hipSuccess || hipDeviceGetAttribute(&cus, hipDeviceAttributeMultiprocessorCount, dev) != hipSuccess) { fprintf(stderr, "kernel_launch: device query failed\n"); grid = -1; return; }
        if (hipFuncSetAttribute((const void*)mk_fwd, hipFuncAttributeMaxDynamicSharedMemorySize, LDS_BYTES) != hipSuccess) { fprintf(stderr, "kernel_launch: hipFuncSetAttribute failed\n"); grid = -1; return; }
        if (hipOccupancyMaxActiveBlocksPerMultiprocessor(&per_cu, (const void*)mk_fwd, NWAVES * 64, LDS_BYTES) != hipSuccess || per_cu < 1) fprintf(stderr, "kernel_launch: note: occupancy query reports %d workgroups per CU\n", per_cu);
        (void)hipGetLastError();
        grid = cus;
    }
    if (grid < 0) return;
    if (hipMemsetAsync((char*)d_ws + WS_CTL, 0, CTL_ZERO_BYTES, stream) != hipSuccess) { fprintf(stderr, "kernel_launch: memset failed\n"); return; }
    Args a{};
    for (int i = 0; i < N_IN; ++i) a.in[i] = (const float*)d_in[i];
    a.out = (float*)d_out; a.ws = (unsigned char*)d_ws;
#if defined(DBG_DUMP)
    for (int p = 0; p < DBG_STOP; ++p) { a.ph_lo = p; a.ph_hi = p + 1; hipLaunchKernelGGL(mk_fwd, dim3(grid), dim3(NWAVES * 64), LDS_BYTES, stream, a); }
    a.ph_lo = N_PHASES; a.ph_hi = N_PHASES + 1; hipLaunchKernelGGL(mk_fwd, dim3(grid), dim3(NWAVES * 64), LDS_BYTES, stream, a);
#elif MK_PER_PHASE
    for (int p = 0; p < N_PHASES; ++p) { a.ph_lo = p; a.ph_hi = p + 1; hipLaunchKernelGGL(mk_fwd, dim3(grid), dim3(NWAVES * 64), LDS_BYTES, stream, a); }
#else
    a.ph_lo = 0; a.ph_hi = N_PHASES;
    hipLaunchKernelGGL(mk_fwd, dim3(grid), dim3(NWAVES * 64), LDS_BYTES, stream, a);
#endif
    const hipError_t le = hipPeekAtLastError();
    if (le != hipSuccess) fprintf(stderr, "kernel_launch: launch failed: %s\n", hipGetErrorName(le));
}
```

```cpp
#include <hip/hip_runtime.h>
#include <cstdio>
#include <cstdint>
namespace pg8 {
#define PG8_LAS __attribute__((address_space(3)))
typedef unsigned short bf16_t;
typedef short bf16x8 __attribute__((ext_vector_type(8)));
typedef float f32x4 __attribute__((ext_vector_type(4)));
typedef float f32x2 __attribute__((ext_vector_type(2)));
typedef unsigned u32x4 __attribute__((ext_vector_type(4)));
typedef unsigned u32x2 __attribute__((ext_vector_type(2)));
constexpr int BM = 256, BK = 64, HALF = 128, HTB = HALF * BK * 2  , STAGE_BYTES = 8 * HTB, NXCD = 8, WGM = 8;

__host__ __device__ __forceinline__ int lds_byte(int r, int c) { const int st = (r >> 4) * 2 + (c >> 5), rr = r & 15, cc = c & 31, ob = rr * 64 + cc * 2; return st * 1024 + (ob ^ (((ob >> 9) & 1) << 5)); }
__host__ __device__ __forceinline__ void stage_rc(int b, int& R, int& C) { const int st = b / 1024, sb = b % 1024, swz = sb ^ (((sb >> 9) & 1) << 5); R = (st >> 1) * 16 + swz / 64; C = (st & 1) * 32 + (swz % 64) / 2; }
__host__ __device__ __forceinline__ int perm32(int rho) { const int n = rho >> 4, i = rho & 15; return 8 * (i >> 2) + 4 * n + (i & 3); }

struct Unit { int pm, pn, ks; };
struct Gemm { const bf16_t* A; const bf16_t* Bt; int M, N, K, lda, ldb, ksA, ksB; };

struct StaticOrder {
    int nM, nN, nwg, G, c, ks_shift;
    __host__ __device__ void init(int M, int N, int G_, int c_, int ks_shift_ = 31) { nM = M / BM; nN = N / BM; nwg = nM * nN; G = G_; c = c_; ks_shift = ks_shift_; }
    __host__ __device__ bool next(int i, Unit& u) const {
        const long L = (long)i * G + c; if (L >= nwg) return false;
        int wgid = (int)L; { const int q = nwg / NXCD, r = nwg % NXCD, xcd = wgid % NXCD, off = wgid / NXCD; wgid = (xcd < r ? xcd * (q + 1) : r * (q + 1) + (xcd - r) * q) + off; }
        const int nig = WGM * nN, gid = wgid / nig, fm = gid * WGM, gsz = (nM - fm) < WGM ? (nM - fm) : WGM;
        u.pm = fm + ((wgid % nig) % gsz); u.pn = (wgid % nig) / gsz; u.ks = u.pn >> ks_shift; return true;
    }
    __device__ __forceinline__ void a_ready(const Unit&) const {}
    __device__ __forceinline__ void done(const Unit&) const {}
};

struct SplitKOrder {
    int pm0, nP, nN, KS, G, c;
    __device__ __forceinline__ bool next(int i, Unit& u) const { const int L = i * G + c; if (L >= nP * nN * KS) return false; u.ks = L % KS; const int t = L / KS; u.pn = t % nN; u.pm = pm0 + t / nN; return true; }
    __device__ __forceinline__ void a_ready(const Unit&) const {}
    __device__ __forceinline__ void done(const Unit&) const {}
};

typedef __bf16 bf16x2_t __attribute__((ext_vector_type(2)));
__device__ __forceinline__ unsigned cvt_pk_bf16(float lo, float hi) { f32x2 v = {lo, hi}; bf16x2_t b = __builtin_convertvector(v, bf16x2_t); return __builtin_bit_cast(unsigned, b); }
__device__ __forceinline__ float fast_sigmoid(float x) { return __builtin_amdgcn_rcpf(1.0f + __builtin_amdgcn_exp2f(-1.4426950408889634f * x)); }

struct EpiF32 {
    static constexpr bool PERM = false, AFTER_DRAIN = false;
    float* C0; int ldc, pm0; size_t ks_stride;
    __device__ __forceinline__ void operator()(const f32x4 (&acc)[2][2][4][2], const Unit& u, int wr, int wc, int fr, int fq) const {
        float* C = C0 + (size_t)u.ks * ks_stride;
        const int row0 = (u.pm - pm0) * BM + wr * 64 + fr, col0 = u.pn * BM + wc * 32 + 4 * fq;
#pragma unroll
        for (int ai = 0; ai < 2; ++ai)
#pragma unroll
            for (int m = 0; m < 4; ++m) { float* rowp = C + (size_t)(row0 + ai * HALF + m * 16) * ldc + col0;
#pragma unroll
                for (int bj = 0; bj < 2; ++bj)
#pragma unroll
                    for (int n = 0; n < 2; ++n) *(f32x4*)(rowp + bj * HALF + n * 16) = acc[ai][bj][m][n]; }
    }
};
struct EpiBf16P {
    static constexpr bool PERM = true, AFTER_DRAIN = false;
    bf16_t* O; int ldc;
    __device__ __forceinline__ void operator()(const f32x4 (&acc)[2][2][4][2], const Unit& u, int wr, int wc, int fr, int fq) const {
        const int row0 = u.pm * BM + wr * 64 + fr, col0 = u.pn * BM + wc * 32 + 8 * fq;
#pragma unroll
        for (int ai = 0; ai < 2; ++ai)
#pragma unroll
            for (int m = 0; m < 4; ++m) { bf16_t* rowp = O + (size_t)(row0 + ai * HALF + m * 16) * ldc + col0;
#pragma unroll
                for (int bj = 0; bj < 2; ++bj) { const f32x4 v0 = acc[ai][bj][m][0], v1 = acc[ai][bj][m][1];
                    u32x4 w; w.x = cvt_pk_bf16(v0[0], v0[1]); w.y = cvt_pk_bf16(v0[2], v0[3]); w.z = cvt_pk_bf16(v1[0], v1[1]); w.w = cvt_pk_bf16(v1[2], v1[3]);
                    *(u32x4*)(rowp + bj * HALF) = w; } }
    }
};
struct EpiSwiGLU {
    static constexpr bool PERM = true, AFTER_DRAIN = false;
    bf16_t* O; int ldo;
    __device__ __forceinline__ void operator()(const f32x4 (&acc)[2][2][4][2], const Unit& u, int wr, int wc, int fr, int fq) const {
        const int row0 = u.pm * BM + wr * 64 + fr, col0 = u.pn * HALF + wc * 32 + 8 * fq;
#pragma unroll
        for (int ai = 0; ai < 2; ++ai)
#pragma unroll
            for (int m = 0; m < 4; ++m) { bf16_t* rowp = O + (size_t)(row0 + ai * HALF + m * 16) * ldo + col0;
                float h[8];
#pragma unroll
                for (int n = 0; n < 2; ++n)
#pragma unroll
                    for (int e = 0; e < 4; ++e) { const float gt = acc[ai][0][m][n][e], up = acc[ai][1][m][n][e]; h[4 * n + e] = gt * up * fast_sigmoid(gt); }
                u32x4 w; w.x = cvt_pk_bf16(h[0], h[1]); w.y = cvt_pk_bf16(h[2], h[3]); w.z = cvt_pk_bf16(h[4], h[5]); w.w = cvt_pk_bf16(h[6], h[7]);
                *(u32x4*)rowp = w; }
    }
};
struct EpiGates {
    static constexpr bool PERM = true, AFTER_DRAIN = false;
    bf16_t* G; const float* br; const float* bi; const float* k8; const bf16_t* XC;
    __device__ __forceinline__ void operator()(const f32x4 (&acc)[2][2][4][2], const Unit& u, int wr, int wc, int fr, int fq) const {
        const int row0 = u.pm * BM + wr * 64 + fr; const int hh = u.pn >> 2, d = (u.pn >> 1) & 1, half = u.pn & 1;
        const int c0 = 256 * hh + 128 * half + 32 * wc + 8 * fq;
        const f32x4 br0 = *(const f32x4*)(br + d * 1024 + c0), br1 = *(const f32x4*)(br + d * 1024 + c0 + 4), bi0 = *(const f32x4*)(bi + d * 1024 + c0), bi1 = *(const f32x4*)(bi + d * 1024 + c0 + 4);
        const f32x4 k80 = *(const f32x4*)(k8 + d * 1024 + c0), k81 = *(const f32x4*)(k8 + d * 1024 + c0 + 4);
#pragma unroll
        for (int ai = 0; ai < 2; ++ai)
#pragma unroll
            for (int m = 0; m < 4; ++m) { const size_t row = (size_t)(row0 + ai * HALF + m * 16); bf16_t* rowp = G + row * 4096 + (2 * d) * 1024 + c0; float la[8], bb[8];
                const u32x4 xw = *(const u32x4*)(XC + row * 1024 + c0);
#pragma unroll
                for (int q = 0; q < 8; ++q) {
                    const float xr = acc[ai][0][m][q >> 2][q & 3] + (q < 4 ? br0[q & 3] : br1[q & 3]), xi = acc[ai][1][m][q >> 2][q & 3] + (q < 4 ? bi0[q & 3] : bi1[q & 3]);
                    const float er = 1.0f + __builtin_amdgcn_exp2f(fminf(-1.4426950408889634f * xr, 60.f)), ei = 1.0f + __builtin_amdgcn_exp2f(fminf(-1.4426950408889634f * xi, 60.f));
                    const float rc = __builtin_amdgcn_rcpf(er * ei), sr = ei * rc, si = er * rc;
                    const unsigned xq = q < 2 ? xw.x : q < 4 ? xw.y : q < 6 ? xw.z : xw.w; const float xc = (q & 1) ? __uint_as_float(xq & 0xffff0000u) : __uint_as_float(xq << 16);
                    la[q] = (q < 4 ? k80[q & 3] : k81[q & 3]) * sr; const float a = __builtin_amdgcn_exp2f(la[q]);
                    bb[q] = __builtin_amdgcn_sqrtf(fmaxf(__builtin_fmaf(-a, a, 1.0f), 0.f)) * (si * xc); }
                u32x4 w; w.x = cvt_pk_bf16(la[0], la[1]); w.y = cvt_pk_bf16(la[2], la[3]); w.z = cvt_pk_bf16(la[4], la[5]); w.w = cvt_pk_bf16(la[6], la[7]);
                *(u32x4*)rowp = w;
                w.x = cvt_pk_bf16(bb[0], bb[1]); w.y = cvt_pk_bf16(bb[2], bb[3]); w.z = cvt_pk_bf16(bb[4], bb[5]); w.w = cvt_pk_bf16(bb[6], bb[7]);
                *(u32x4*)(rowp + 1024) = w;
                if (m & 1) asm volatile("" ::: "memory"); }
    }
};
struct EpiMixIn {
    static constexpr bool PERM = true, AFTER_DRAIN = false;
    bf16_t* P; bf16_t* U;
    __device__ __forceinline__ void operator()(const f32x4 (&acc)[2][2][4][2], const Unit& u, int wr, int wc, int fr, int fq) const {
        const int row0 = u.pm * BM + wr * 64 + fr;
        if (u.pn < 8) {
            const int col0 = u.pn * BM + wc * 32 + 8 * fq;
#pragma unroll
            for (int ai = 0; ai < 2; ++ai)
#pragma unroll
                for (int m = 0; m < 4; ++m) { bf16_t* rowp = P + (size_t)(row0 + ai * HALF + m * 16) * 2048 + col0;
#pragma unroll
                    for (int bj = 0; bj < 2; ++bj) { const f32x4 v0 = acc[ai][bj][m][0], v1 = acc[ai][bj][m][1];
                        u32x4 w; w.x = cvt_pk_bf16(v0[0], v0[1]); w.y = cvt_pk_bf16(v0[2], v0[3]); w.z = cvt_pk_bf16(v1[0], v1[1]); w.w = cvt_pk_bf16(v1[2], v1[3]);
                        *(u32x4*)(rowp + bj * HALF) = w; } }
        } else {
            const int col0 = (u.pn - 8) * HALF + wc * 32 + 8 * fq;
#pragma unroll
            for (int ai = 0; ai < 2; ++ai)
#pragma unroll
                for (int m = 0; m < 4; ++m) { bf16_t* rowp = U + (size_t)(row0 + ai * HALF + m * 16) * 1024 + col0; float h[8];
#pragma unroll
                    for (int n = 0; n < 2; ++n)
#pragma unroll
                        for (int e = 0; e < 4; ++e) h[4 * n + e] = acc[ai][0][m][n][e] * fast_sigmoid(acc[ai][1][m][n][e]);
                    u32x4 w; w.x = cvt_pk_bf16(h[0], h[1]); w.y = cvt_pk_bf16(h[2], h[3]); w.z = cvt_pk_bf16(h[4], h[5]); w.w = cvt_pk_bf16(h[6], h[7]);
                    *(u32x4*)rowp = w; }
        }
    }
};

template <class Epi, class Sched, bool ALIGN_EPI = false, bool SP2 = false>
__device__ __forceinline__ void gemm_phase(PG8_LAS unsigned char* lds, const Gemm g, const Sched& S, const Epi& E) {
    int tid_ = threadIdx.x; asm volatile("" : "+v"(tid_));
    const int tid = tid_, wid = __builtin_amdgcn_readfirstlane(tid >> 6), lane = tid & 63, wr = wid >> 2, wc = wid & 3, fr = lane & 15, fq = lane >> 4;
    const int K = g.K, nt = K / BK;
    unsigned voffA[2], voffB[2];
#pragma unroll
    for (int i = 0; i < 2; ++i) { int R, C; stage_rc(tid * 16 + i * 8192, R, C); const int Rb = Epi::PERM ? ((R & ~31) + perm32(R & 31)) : R;
        voffA[i] = (unsigned)(R * g.lda + C) * 2u; voffB[i] = (unsigned)(Rb * g.ldb + C) * 2u; }
    const size_t kstep = (size_t)(BK * 2);
    const size_t hsA = (size_t)HALF * g.lda * 2, hsB = (size_t)HALF * g.ldb * 2;
    const size_t tsA = 2 * hsA, tsB = 2 * hsB;
    const unsigned ldsw = (unsigned)wid * 1024u;
    const int aoff = lds_byte(wr * 64 + fr, fq * 8), boff = lds_byte(wc * 32 + fr, fq * 8);
#define PG8_SA(b, h) (((b) * 2 + (h)) * HTB)
#define PG8_SB(b, h) ((4 + (b) * 2 + (h)) * HTB)
#define PG8_STAGE(bufoff, gbase, voff) do { _Pragma("unroll") for (int _i = 0; _i < 2; ++_i) \
        __builtin_amdgcn_global_load_lds((const unsigned*)((const char*)(gbase) + (voff)[_i]), (PG8_LAS unsigned*)(lds + (bufoff) + ldsw + _i * 8192), 16, 0, 0); } while (0)
#define PG8_LDA(dst, b, h) do { _Pragma("unroll") for (int m = 0; m < 4; ++m) _Pragma("unroll") for (int k = 0; k < 2; ++k) dst[m][k] = *(const PG8_LAS bf16x8*)(lds + PG8_SA(b, h) + aoff + m * 2048 + k * 1024); } while (0)
#define PG8_LDB(dst, b, h) do { _Pragma("unroll") for (int n = 0; n < 2; ++n) _Pragma("unroll") for (int k = 0; k < 2; ++k) dst[n][k] = *(const PG8_LAS bf16x8*)(lds + PG8_SB(b, h) + boff + n * 2048 + k * 1024); } while (0)
#define PG8_MMA(ai, bj, At, Bt) do { __builtin_amdgcn_s_setprio(1); _Pragma("unroll") for (int m = 0; m < 4; ++m) _Pragma("unroll") for (int n = 0; n < 2; ++n) _Pragma("unroll") for (int k = 0; k < 2; ++k) \
        acc[ai][bj][m][n] = __builtin_amdgcn_mfma_f32_16x16x32_bf16(Bt[n][k], At[m][k], acc[ai][bj][m][n], 0, 0, 0); __builtin_amdgcn_s_setprio(0); } while (0)
#define PG8_WAIT_V(n) asm volatile("s_waitcnt vmcnt(" #n ")" ::: "memory")
#define PG8_WAIT_L(n) asm volatile("s_waitcnt lgkmcnt(" #n ")" ::: "memory")
#define PG8_BAR __builtin_amdgcn_s_barrier()
#define PG8_SCHED __builtin_amdgcn_sched_barrier(0)
    Unit cur, nxt; int ui = 0;
    if (!S.next(0, cur)) return;
    f32x4 acc[2][2][4][2];
#pragma unroll
    for (int a = 0; a < 2; ++a)
#pragma unroll
        for (int b = 0; b < 2; ++b)
#pragma unroll
            for (int m = 0; m < 4; ++m)
#pragma unroll
                for (int n = 0; n < 2; ++n) acc[a][b][m][n] = (f32x4){0.f, 0.f, 0.f, 0.f};
    bf16x8 At[4][2], B0[2][2], B1[2][2];
    const char* cA = (const char*)g.A + (size_t)cur.pm * tsA + (size_t)cur.ks * g.ksA; const char* cB = (const char*)g.Bt + (size_t)cur.pn * tsB + (size_t)cur.ks * g.ksB;
    S.a_ready(cur);
    if constexpr (SP2) {
        PG8_STAGE(PG8_SB(0, 0), cB, voffB); PG8_STAGE(PG8_SB(0, 1), cB + hsB, voffB); PG8_STAGE(PG8_SA(0, 0), cA, voffA); PG8_STAGE(PG8_SA(0, 1), cA + hsA, voffA);
        if (wr == 1) PG8_BAR;
        PG8_WAIT_V(2); PG8_BAR;
        PG8_STAGE(PG8_SB(1, 0), cB + kstep, voffB); PG8_STAGE(PG8_SA(1, 0), cA + kstep, voffA); PG8_STAGE(PG8_SB(1, 1), cB + hsB + kstep, voffB);
        PG8_WAIT_V(6); PG8_BAR;
    } else {
        PG8_STAGE(PG8_SB(0, 0), cB, voffB); PG8_STAGE(PG8_SA(0, 0), cA, voffA); PG8_STAGE(PG8_SB(0, 1), cB + hsB, voffB); PG8_STAGE(PG8_SA(0, 1), cA + hsA, voffA);
        if (wr == 1) PG8_BAR;
        PG8_WAIT_V(4); PG8_BAR;
        PG8_STAGE(PG8_SB(1, 0), cB + kstep, voffB); PG8_STAGE(PG8_SA(1, 0), cA + kstep, voffA); PG8_STAGE(PG8_SB(1, 1), cB + hsB + kstep, voffB);
        PG8_WAIT_V(6); PG8_BAR;
    }
    for (;;) {
        const bool has_next = S.next(ui + 1, nxt);
        const char* nA = has_next ? (const char*)g.A + (size_t)nxt.pm * tsA + (size_t)nxt.ks * g.ksA : cA; const char* nB = has_next ? (const char*)g.Bt + (size_t)nxt.pn * tsB + (size_t)nxt.ks * g.ksB : cB;
        for (int t = 0; t < nt; t += 2) {
            const bool last = (t == nt - 2);
            const char* a1 = cA + (size_t)(t + 1) * kstep;
            const char* a2 = last ? nA : cA + (size_t)(t + 2) * kstep; const char* b2 = last ? nB : cB + (size_t)(t + 2) * kstep;
            const char* a3 = a2 + kstep; const char* b3 = b2 + kstep;
            if (last && has_next) S.a_ready(nxt);
            if constexpr (SP2) {
            PG8_LDB(B0, 0, 0); PG8_LDB(B1, 0, 1); PG8_SCHED; PG8_LDA(At, 0, 0); PG8_STAGE(PG8_SA(1, 1), a1 + hsA, voffA);
            PG8_WAIT_V(8); PG8_WAIT_L(0); PG8_BAR; PG8_MMA(0, 0, At, B0); PG8_MMA(0, 1, At, B1); PG8_BAR; PG8_SCHED;
            PG8_LDA(At, 0, 1); PG8_STAGE(PG8_SB(0, 0), b2, voffB); PG8_STAGE(PG8_SB(0, 1), b2 + hsB, voffB); PG8_STAGE(PG8_SA(0, 0), a2, voffA);
            PG8_WAIT_V(8); PG8_WAIT_L(0); PG8_BAR; PG8_MMA(1, 0, At, B0); PG8_MMA(1, 1, At, B1); PG8_BAR; PG8_SCHED;
            PG8_LDB(B0, 1, 0); PG8_LDB(B1, 1, 1); PG8_SCHED; PG8_LDA(At, 1, 0); PG8_STAGE(PG8_SA(0, 1), a2 + hsA, voffA);
            PG8_WAIT_V(8); PG8_WAIT_L(0); PG8_BAR; PG8_MMA(0, 0, At, B0); PG8_MMA(0, 1, At, B1); PG8_BAR; PG8_SCHED;
            PG8_LDA(At, 1, 1); PG8_STAGE(PG8_SB(1, 0), b3, voffB); PG8_STAGE(PG8_SB(1, 1), b3 + hsB, voffB); PG8_STAGE(PG8_SA(1, 0), a3, voffA);
            PG8_WAIT_V(8); PG8_WAIT_L(0); PG8_BAR; PG8_MMA(1, 0, At, B0); PG8_MMA(1, 1, At, B1); PG8_BAR; PG8_SCHED;
            } else {
            PG8_LDB(B0, 0, 0); PG8_SCHED; PG8_LDA(At, 0, 0); PG8_STAGE(PG8_SA(1, 1), a1 + hsA, voffA);
            PG8_WAIT_L(8); PG8_BAR; PG8_WAIT_L(0); PG8_MMA(0, 0, At, B0); PG8_BAR; PG8_SCHED;
            PG8_LDB(B1, 0, 1); PG8_STAGE(PG8_SB(0, 0), b2, voffB);
            PG8_BAR; PG8_WAIT_L(0); PG8_MMA(0, 1, At, B1); PG8_BAR;
            PG8_LDA(At, 0, 1); PG8_STAGE(PG8_SA(0, 0), a2, voffA);
            PG8_BAR; PG8_WAIT_L(0); PG8_MMA(1, 0, At, B0); PG8_BAR; PG8_SCHED;
            PG8_STAGE(PG8_SB(0, 1), b2 + hsB, voffB);
            PG8_WAIT_V(6); PG8_BAR; PG8_MMA(1, 1, At, B1); PG8_BAR;
            PG8_LDB(B0, 1, 0); PG8_SCHED; PG8_LDA(At, 1, 0); PG8_STAGE(PG8_SA(0, 1), a2 + hsA, voffA);
            PG8_WAIT_L(8); PG8_BAR; PG8_WAIT_L(0); PG8_MMA(0, 0, At, B0); PG8_BAR; PG8_SCHED;
            PG8_LDB(B1, 1, 1); PG8_STAGE(PG8_SB(1, 0), b3, voffB);
            PG8_BAR; PG8_WAIT_L(0); PG8_MMA(0, 1, At, B1); PG8_BAR;
            PG8_LDA(At, 1, 1); PG8_STAGE(PG8_SA(1, 0), a3, voffA);
            PG8_BAR; PG8_WAIT_L(0); PG8_MMA(1, 0, At, B0); PG8_BAR; PG8_SCHED;
            PG8_STAGE(PG8_SB(1, 1), b3 + hsB, voffB);
            PG8_WAIT_V(6); PG8_BAR; PG8_MMA(1, 1, At, B1); PG8_BAR;
            }
        }
        if constexpr (ALIGN_EPI) { if (wr == 0) PG8_BAR; }
        if constexpr (!Epi::AFTER_DRAIN) { E(acc, cur, wr, wc, fr, fq); S.done(cur); }
        if (!has_next) break;
#pragma unroll
        for (int a = 0; a < 2; ++a)
#pragma unroll
            for (int b = 0; b < 2; ++b)
#pragma unroll
                for (int m = 0; m < 4; ++m)
#pragma unroll
                    for (int n = 0; n < 2; ++n) acc[a][b][m][n] = (f32x4){0.f, 0.f, 0.f, 0.f};
        cur = nxt; cA = nA; cB = nB; ++ui;
        if constexpr (ALIGN_EPI) { if (wr == 1) PG8_BAR; }
    }
    PG8_WAIT_V(0);
    if constexpr (!ALIGN_EPI) { if (wr == 0) PG8_BAR; }
    PG8_BAR;
    if constexpr (Epi::AFTER_DRAIN) { E.fused(acc, cur, wr, wc, fr, fq, lds, wid, lane); S.done(cur); }
#undef PG8_SA
#undef PG8_SB
#undef PG8_STAGE
#undef PG8_LDA
#undef PG8_LDB
#undef PG8_MMA
#undef PG8_WAIT_V
#undef PG8_WAIT_L
#undef PG8_BAR
#undef PG8_SCHED
}
}

constexpr int NWAVES = 8;
constexpr int D = 2048, BATCH = 2, SEQ = 8192, CTXL = 256, DEPTH = 2;
constexpr int RL = BATCH * SEQ, RC = BATCH * CTXL, R = RL + RC;
constexpr int DFF = 5632, NFF = 2 * DFF, DLRU = 1024, DCONV = 1024, DIN = 4096, NMOD = 9, NADA = NMOD * D;
constexpr int CONVK = 31, GRIDW = 64;
constexpr float LN_EPS = 1e-6f, ALPHA = 1.41421356237309515f;
constexpr int SUBL = 32, NSUB = R / SUBL;
#ifndef MK_PER_PHASE
#define MK_PER_PHASE 0
#endif
constexpr int N_PHASES = 2 + 14 * DEPTH;
constexpr int KS_FFN = 11, KS_WOUT = 8, KS_MIX = 8;
constexpr int PLD = 2 * DLRU;

enum { I_X = 0, I_C, I_CTX, I_CCTX, I_WADA, I_BADA, I_LNG, I_LNB, I_FF1IN, I_FF1OUT, I_FF2IN, I_FF2OUT, I_WIN, I_C4W, I_C4B, I_WRG, I_BRG, I_WIG, I_BIG, I_LAM, I_C31W, I_C31B, I_CLNG, I_CLNB, I_WOUT, I_BOUT, N_IN };

constexpr size_t MiB = 1u << 20;
constexpr size_t WS_CTL = 0, CTL_ZERO_BYTES = 1 * MiB;
constexpr size_t WS_MOD = 1 * MiB;
constexpr size_t WS_SA = 2 * MiB, WS_SB = 7 * MiB, WS_HIN = 12 * MiB;
constexpr size_t WS_W1T = 17 * MiB;
constexpr size_t WS_W2T = 193 * MiB;
constexpr size_t WS_WINT = 281 * MiB;
constexpr size_t WS_WOUTT = 313 * MiB;
constexpr size_t WS_WGT = 329 * MiB;
constexpr size_t WS_XS = 333 * MiB;
constexpr size_t WS_A = 465 * MiB;
constexpr size_t WS_F = 531 * MiB;
constexpr size_t WS_HID = 663 * MiB;
constexpr size_t WS_Y = 845 * MiB;
constexpr size_t WS_SLAB = 911 * MiB;
constexpr size_t WS_PSLAB = 955 * MiB;
constexpr size_t WS_END = 1019 * MiB;
static_assert(WS_W1T + (size_t)4 * NFF * D * 2 <= WS_W2T && WS_W2T + (size_t)4 * D * DFF * 2 <= WS_WINT && WS_WINT + (size_t)2 * DIN * D * 2 <= WS_WOUTT && WS_WOUTT + (size_t)2 * D * D * 2 <= WS_WGT && WS_WGT + (size_t)2 * 4096 * 256 * 2 <= WS_XS, "ws map (weights)");
static_assert(WS_XS + (size_t)R * D * 4 <= WS_A && WS_A + (size_t)R * D * 2 <= WS_F && WS_F + (size_t)R * D * 4 <= WS_HID && WS_HID + (size_t)R * DFF * 2 <= WS_Y && WS_Y + (size_t)R * D * 2 <= WS_SLAB && WS_SLAB + (size_t)11 * RC * D * 4 <= WS_PSLAB && WS_PSLAB + (size_t)8 * RC * DIN * 4 <= WS_END, "ws map (activations)");
static_assert((size_t)R * DIN * 2 <= (size_t)R * D * 4 && (size_t)R * 4096 * 2 + (size_t)R * 1024 * 2 <= (size_t)R * DFF * 2 && (size_t)NSUB * 2 * 1024 * 4 <= 5 * MiB, "ws overlays");
constexpr int CW_TMO = 0, CW_CODE = 1, CW_BAR = 4096, CW_Q = 8192;

constexpr int RING_OFF = 0, RING_BYTES = 131072;
constexpr int LDSCTL_OFF = RING_BYTES, MISC_OFF = LDSCTL_OFF + 320;
constexpr int LDS_BYTES = 147456;

#define GAS __attribute__((address_space(1)))
#define LAS __attribute__((address_space(3)))
typedef unsigned short bf16;
typedef unsigned v4u __attribute__((ext_vector_type(4)));
typedef unsigned v2u __attribute__((ext_vector_type(2)));
typedef float f32x4 __attribute__((ext_vector_type(4)));
typedef float f32x2 __attribute__((ext_vector_type(2)));
typedef GAS unsigned gu32;
typedef _Float16 f16x4 __attribute__((ext_vector_type(4)));
#define RLX_AGENT __ATOMIC_RELAXED, __HIP_MEMORY_SCOPE_AGENT
#define LDS_WAIT() asm volatile("s_waitcnt lgkmcnt(0)" ::: "memory")
#define VM_WAIT() asm volatile("s_waitcnt vmcnt(0)" ::: "memory")
__device__ __forceinline__ unsigned f2bf(float f) { unsigned u = __builtin_bit_cast(unsigned, f); return (u + 0x7fffu + ((u >> 16) & 1u)) >> 16; }
__device__ __forceinline__ unsigned pk2(float lo, float hi) { return pg8::cvt_pk_bf16(lo, hi); }
__device__ __forceinline__ float bflo(unsigned u) { return __uint_as_float(u << 16); }
__device__ __forceinline__ float bfhi(unsigned u) { return __uint_as_float(u & 0xffff0000u); }
__device__ __forceinline__ float sigm(float x) { return __builtin_amdgcn_rcpf(1.0f + __builtin_amdgcn_exp2f(-1.4426950408889634f * x)); }
template <int CTRL> __device__ __forceinline__ float dpp_mov(float v) { return __builtin_bit_cast(float, __builtin_amdgcn_update_dpp(0, __builtin_bit_cast(int, v), CTRL, 0xf, 0xf, true)); }
__device__ __forceinline__ float wave_sum(float v) {
    v += dpp_mov<0xB1>(v); v += dpp_mov<0x4E>(v); v += dpp_mov<0x141>(v); v += dpp_mov<0x140>(v);
    { auto r = __builtin_amdgcn_permlane16_swap(__float_as_uint(v), __float_as_uint(v), false, false); v = __uint_as_float(r[0]) + __uint_as_float(r[1]); }
    { auto r = __builtin_amdgcn_permlane32_swap(__float_as_uint(v), __float_as_uint(v), false, false); v = __uint_as_float(r[0]) + __uint_as_float(r[1]); }
    return v;
}

#define XB_TMO      128
#define XB_XCNT(j)  (256  + 64 * (j))
#define XB_XSUB(j)  (1280 + 64 * (j))
#define XB_XGEN(j)  (2304 + 64 * (j))
#define XB_TOP      3328
#define XB_TOPGEN   3392
#define XCD_BAR_WORDS 3456
#define XB_SPIN_CAP (1u << 18)

__device__ __forceinline__ unsigned xb_ld(unsigned* p)              { return __hip_atomic_load(p, __ATOMIC_RELAXED, __HIP_MEMORY_SCOPE_AGENT); }
__device__ __forceinline__ unsigned xb_add(unsigned* p, unsigned v) { return __hip_atomic_fetch_add(p, v, __ATOMIC_RELAXED, __HIP_MEMORY_SCOPE_AGENT); }
__device__ __forceinline__ unsigned xb_xcc_id() { return (unsigned)__builtin_amdgcn_s_getreg((3 << 11) | 20) & 0xFu; }
#define XB_SPIN(cond, bar) do { unsigned _sp = 0; while (cond) { __builtin_amdgcn_s_sleep(1); \
    if ((++_sp & 255u) == 0u) { if (xb_ld(&(bar)[XB_TMO])) break; if (_sp > XB_SPIN_CAP) { atomicAdd(&(bar)[XB_TMO], 1u); break; } } } } while (0)

struct XcdBarrier {
    unsigned* bar; unsigned x;
    volatile LAS unsigned* st;
};
__device__ __forceinline__ XcdBarrier xcd_barrier_post(unsigned* bar, volatile LAS unsigned* st) {
    XcdBarrier b; b.bar = bar; b.x = xb_xcc_id(); b.st = st;
    if (threadIdx.x == 0) (void)xb_add(&bar[XB_XCNT(b.x)], 1u);
    return b;
}
__device__ __forceinline__ void xcd_barrier_complete(unsigned* bar, unsigned x, unsigned& nloc, unsigned& nx) {
    const unsigned G = gridDim.x * gridDim.y * gridDim.z;
    unsigned sum, cnt, mine, sp = 0u;
    for (;;) {
        sum = 0u; cnt = 0u; mine = 0u;
#pragma unroll
        for (unsigned j = 0; j < 16; ++j) { const unsigned c = xb_ld(&bar[XB_XCNT(j)]); sum += c; cnt += (c > 0u) ? 1u : 0u; mine = (j == x) ? c : mine; }
        if (sum == G) break;
        __builtin_amdgcn_s_sleep(1);
        if ((++sp & 255u) == 0u) { if (xb_ld(&bar[XB_TMO])) break; if (sp > XB_SPIN_CAP) { atomicAdd(&bar[XB_TMO], 1u); break; } }
    }
    nloc = mine > 0u ? mine : 1u; nx = cnt > 0u ? cnt : 1u;
}
__device__ __forceinline__ void xcd_barrier(const XcdBarrier& b) {
    asm volatile("s_waitcnt vmcnt(0)" ::: "memory");
    __syncthreads();
    if (threadIdx.x == 0) {
        unsigned* bar = b.bar;
        __builtin_amdgcn_s_waitcnt(0);
        unsigned nloc = b.st[0], nx = b.st[1];
        if (nloc == 0u) { xcd_barrier_complete(bar, b.x, nloc, nx); b.st[0] = nloc; b.st[1] = nx; }
        const unsigned old = xb_add(&bar[XB_XSUB(b.x)], 1u);
        const unsigned gen = old / nloc;
        if (old + 1u == (gen + 1u) * nloc) {
            __builtin_amdgcn_fence(__ATOMIC_RELEASE, "agent");
            asm volatile("s_waitcnt vmcnt(0)" ::: "memory");
            const unsigned og = xb_add(&bar[XB_TOP], 1u);
            const unsigned tg = og / nx;
            if (og + 1u == (tg + 1u) * nx) xb_add(&bar[XB_TOPGEN], 1u);
            else XB_SPIN(xb_ld(&bar[XB_TOPGEN]) == tg, bar);
            __builtin_amdgcn_fence(__ATOMIC_ACQUIRE, "agent");
            xb_add(&bar[XB_XGEN(b.x)], 1u);
            asm volatile("s_waitcnt vmcnt(0)" ::: "memory");
        } else {
            XB_SPIN(xb_ld(&bar[XB_XGEN(b.x)]) == gen, bar);
            __builtin_amdgcn_fence(__ATOMIC_ACQUIRE, "agent");
            asm volatile("s_waitcnt vmcnt(0)" ::: "memory");
        }
    }
    __syncthreads();
}

struct Frame {
    LAS unsigned char* lds;
    gu32* ctl;
    int tid, lane, wave, G;
    const float* in[N_IN]; float* out;
    float* MOD; float *SA, *SB, *HIN;
    bf16 *W1T, *W2T, *WINT, *WOUTT, *WGT;
    _Float16* XS; bf16* A; bf16* Fb; bf16* P; bf16* HID; bf16* GT; bf16* XC; bf16* Y; float* SLAB; float* PSLAB; bf16* U; float* K8;
};

__device__ __forceinline__ void fresh(Frame& F) { int t = threadIdx.x; asm volatile("" : "+v"(t)); F.tid = t; F.lane = t & 63; F.wave = __builtin_amdgcn_readfirstlane(t >> 6); }
__device__ __forceinline__ void transpose_item(const float* W, int ldw, int src_col, bf16* WT, int ldk, int dst_row, int k0, LAS float* scr, int lane) {
    const int c4 = (lane & 7) * 4, kr = lane >> 3; f32x4 v[8];
#pragma unroll
    for (int i = 0; i < 8; ++i) v[i] = *(const f32x4*)(W + (size_t)(k0 + 8 * i + kr) * ldw + src_col + c4);
#pragma unroll
    for (int i = 0; i < 8; ++i) { LAS float* d = scr + (8 * i + kr) * 33 + c4; d[0] = v[i][0]; d[1] = v[i][1]; d[2] = v[i][2]; d[3] = v[i][3]; }
    LDS_WAIT(); asm volatile("" ::: "memory");
    const int c = lane & 7;
#pragma unroll
    for (int j = 0; j < 4; ++j) { const int n = (lane >> 3) + 8 * j; const LAS float* s = scr + (8 * c) * 33 + n;
        v4u o; o.x = pk2(s[0 * 33], s[1 * 33]); o.y = pk2(s[2 * 33], s[3 * 33]); o.z = pk2(s[4 * 33], s[5 * 33]); o.w = pk2(s[6 * 33], s[7 * 33]);
        *(v4u*)(WT + (size_t)(dst_row + n) * ldk + k0 + 8 * c) = o; }
    LDS_WAIT(); asm volatile("" ::: "memory");
}
constexpr int IT_FIN = (D / 64) * (NFF / 32), IT_FOUT = (DFF / 64) * (D / 32), IT_WIN = (D / 64) * (DIN / 32), IT_WOUT = (D / 64) * (D / 32), IT_G = (256 / 64) * (4096 / 32);
constexpr int CV_LAYER_ITEMS = 2 * IT_FIN + 2 * IT_FOUT + IT_WIN + IT_WOUT + IT_G;
#ifndef CV_TAIL_PCT
#define CV_TAIL_PCT 100
#endif
constexpr int CV_TAIL_ITEMS = (int)((long)CV_LAYER_ITEMS * CV_TAIL_PCT / 100);
__device__ __forceinline__ void convert_layer_items(Frame& F, int l, int it_begin, int it_end, int widx, int nw) {
    LAS float* scr = (LAS float*)(F.lds + RING_OFF + F.wave * 16384);
    for (int it = it_begin + widx; it < it_end; it += nw) {
        int r = it;
#define CV_FIN(f) { const int kb = r / (NFF / 32), nb = r % (NFF / 32), dst_row = 32 * nb, pn = dst_row >> 8, lc = dst_row & 255, src_col = lc < 128 ? 128 * pn + lc : DFF + 128 * pn + (lc - 128); \
            transpose_item(F.in[(f) ? I_FF2IN : I_FF1IN] + (size_t)l * D * NFF, NFF, src_col, F.W1T + (size_t)(l * 2 + (f)) * NFF * D, D, dst_row, 64 * kb, scr, F.lane); continue; }
#define CV_FOUT(f) { const int kb = r / (D / 32), nb = r % (D / 32); \
            transpose_item(F.in[(f) ? I_FF2OUT : I_FF1OUT] + (size_t)l * DFF * D, D, 32 * nb, F.W2T + (size_t)(l * 2 + (f)) * D * DFF, DFF, 32 * nb, 64 * kb, scr, F.lane); continue; }
        if (r < IT_FIN) CV_FIN(0)
        r -= IT_FIN;
        if (r < IT_FOUT) CV_FOUT(0)
        r -= IT_FOUT;
        if (r < IT_WIN) { const int kb = r / (DIN / 32), nb = r % (DIN / 32);
            const int dst_row = 32 * nb, tt = (dst_row - 2 * DLRU) >> 8, lc = dst_row & 255;
            const int src_col = dst_row < 2 * DLRU ? dst_row : (lc < 128 ? 2 * DLRU + 128 * tt + lc : 3 * DLRU + 128 * tt + (lc - 128));
            transpose_item(F.in[I_WIN] + (size_t)l * D * DIN, DIN, src_col, F.WINT + (size_t)l * DIN * D, D, dst_row, 64 * kb, scr, F.lane); continue; }
        r -= IT_WIN;
        if (r < IT_G) { const int kb = r / 128, nb = r % 128; const int dst_row = 32 * nb, pn = dst_row >> 8, lc = dst_row & 255, hh = pn >> 2, d = (pn >> 1) & 1, half = pn & 1;
            const float* src = F.in[lc < 128 ? I_WRG : I_WIG] + (size_t)((l * 2 + d) * 4 + hh) * 65536;
            transpose_item(src, 256, 128 * half + (lc & 127), F.WGT + (size_t)l * 4096 * 256, 256, dst_row, 64 * kb, scr, F.lane); continue; }
        r -= IT_G;
        if (r < IT_WOUT) { const int kb = r / (D / 32), nb = r % (D / 32);
            transpose_item(F.in[I_WOUT] + (size_t)l * D * D, D, 32 * nb, F.WOUTT + (size_t)l * D * D, D, 32 * nb, 64 * kb, scr, F.lane); continue; }
        r -= IT_WOUT;
        if (r < IT_FIN) CV_FIN(1)
        r -= IT_FIN;
        CV_FOUT(1)
#undef CV_FIN
#undef CV_FOUT
    }
}
__device__ __forceinline__ void convert_in_tail(Frame& F, int lconv, int it_begin, int it_end, int nunits) {
    fresh(F);
    const int first = nunits % F.G, nwg = F.G - first;
    if ((int)blockIdx.x < first) return;
    convert_layer_items(F, lconv, it_begin, it_end, ((int)blockIdx.x - first) * NWAVES + F.wave, nwg * NWAVES);
}
constexpr int CV_S2 = IT_FIN + IT_FOUT + IT_WIN + IT_G + IT_WOUT, CV_S1 = CV_S2 / 2;
__device__ __forceinline__ void prologue_a(Frame& F) {
    fresh(F);
    {
        LAS float* sv = (LAS float*)(F.lds + RING_OFF);
        LAS float* red = (LAS float*)(F.lds + RING_OFF + 32768);
#pragma unroll
        for (int i = F.tid; i < 3 * D; i += NWAVES * 64) { const int v = i >> 11, k = i & (D - 1); const float cv = v < 2 ? F.in[I_C][v * D + k] : F.in[I_CCTX][k]; sv[i] = cv * sigm(cv); }
        __syncthreads();
        const int cg = F.lane & 15, rg = F.lane >> 4;
#ifndef DUP_ADA
#define DUP_ADA 0
#endif
        for (int rep2 = 0; rep2 <= DUP_ADA; ++rep2)
        for (int it = blockIdx.x; it < DEPTH * (NADA / 64); it += F.G) {
            const int l = it / (NADA / 64), n0 = (it % (NADA / 64)) * 64;
            const float* W = F.in[I_WADA] + (size_t)l * D * NADA + n0 + 4 * cg;
            f32x4 a0 = {0.f, 0.f, 0.f, 0.f}, a1 = a0, a2 = a0;
#pragma unroll 8
            for (int kk = 0; kk < 64; ++kk) { const int k = F.wave * 256 + kk * 4 + rg; const f32x4 w = *(const f32x4*)(W + (size_t)k * NADA);
                a0 += w * sv[k]; a1 += w * sv[D + k]; a2 += w * sv[2 * D + k]; }
#pragma unroll
            for (int e = 0; e < 4; ++e) { a0[e] += __shfl_xor(a0[e], 16); a0[e] += __shfl_xor(a0[e], 32); a1[e] += __shfl_xor(a1[e], 16); a1[e] += __shfl_xor(a1[e], 32); a2[e] += __shfl_xor(a2[e], 16); a2[e] += __shfl_xor(a2[e], 32); }
            if (rg == 0) {
#pragma unroll
                for (int e = 0; e < 4; ++e) { red[(F.wave * 3 + 0) * 64 + 4 * cg + e] = a0[e]; red[(F.wave * 3 + 1) * 64 + 4 * cg + e] = a1[e]; red[(F.wave * 3 + 2) * 64 + 4 * cg + e] = a2[e]; }
            }
            __syncthreads();
            if (F.tid < 192) { const int v = F.tid >> 6, n = F.tid & 63; float s = F.in[I_BADA][(size_t)l * NADA + n0 + n];
#pragma unroll
                for (int w = 0; w < 8; ++w) s += red[(w * 3 + v) * 64 + n];
                F.MOD[((size_t)l * 3 + v) * NADA + n0 + n] = s; }
            __syncthreads();
        }
    }
    for (int i = blockIdx.x * (NWAVES * 64) + F.tid; i < DEPTH * 2 * DLRU; i += F.G * NWAVES * 64) F.K8[i] = -8.0f * 1.4426950408889634f * log1pf(expf(-F.in[I_LAM][i]));
    convert_layer_items(F, 0, 0, CV_LAYER_ITEMS, blockIdx.x * NWAVES + F.wave, F.G * NWAVES);
}
__device__ __forceinline__ void init_phase(Frame& F) {
    fresh(F);
    const int gw = blockIdx.x * NWAVES + F.wave, NGW = F.G * NWAVES;
    for (int row0 = gw; row0 < R; row0 += 2 * NGW) {
        f32x4 xv[2][8];
#pragma unroll
        for (int h = 0; h < 2; ++h) { const int row = row0 + h * NGW; if (row < R) { const float* src = row < RL ? F.in[I_X] + (size_t)row * D : F.in[I_CTX] + (size_t)(row - RL) * D;
#pragma unroll
            for (int j = 0; j < 8; ++j) xv[h][j] = *(const f32x4*)(src + 8 * F.lane + 512 * (j >> 1) + 4 * (j & 1)); } }
#pragma unroll
        for (int h = 0; h < 2; ++h) { const int row = row0 + h * NGW; if (row < R) { const float* m = F.MOD + (size_t)(row < RL ? (row >> 13) : 2) * NADA;
#pragma unroll
            for (int q = 0; q < 4; ++q) { const int col = 8 * F.lane + 512 * q;
                const f32x4 a0 = xv[h][2 * q] * (1.0f + *(const f32x4*)(m + D + col)) + *(const f32x4*)(m + col), a1 = xv[h][2 * q + 1] * (1.0f + *(const f32x4*)(m + D + col + 4)) + *(const f32x4*)(m + col + 4);
                v4u o; o.x = pk2(a0[0], a0[1]); o.y = pk2(a0[2], a0[3]); o.z = pk2(a1[0], a1[1]); o.w = pk2(a1[2], a1[3]);
                *(v4u*)(F.A + (size_t)row * D + col) = o; } } }
    }
}
#define LN_COL(lane, j) (8 * (lane) + 512 * ((j) >> 1) + 4 * ((j) & 1))
typedef _Float16 f16x8 __attribute__((ext_vector_type(8)));
__device__ __forceinline__ void ln_load(const float* xin, const _Float16* xh, const bf16* fb, const float* fs, int nks, int lane, f32x4 (&x)[8], f32x4 (&f)[8]) {
    if (xin) {
#pragma unroll
        for (int j = 0; j < 8; ++j) x[j] = *(const f32x4*)(xin + LN_COL(lane, j));
    } else {
#pragma unroll
        for (int q = 0; q < 4; ++q) { const f16x8 h = *(const f16x8*)(xh + LN_COL(lane, 2 * q));
            x[2 * q] = (f32x4){(float)h[0], (float)h[1], (float)h[2], (float)h[3]}; x[2 * q + 1] = (f32x4){(float)h[4], (float)h[5], (float)h[6], (float)h[7]}; }
    }
    if (nks == 0) {
#pragma unroll
        for (int q = 0; q < 4; ++q) { const v4u w = *(const v4u*)(fb + LN_COL(lane, 2 * q));
            f[2 * q] = (f32x4){bflo(w.x), bfhi(w.x), bflo(w.y), bfhi(w.y)}; f[2 * q + 1] = (f32x4){bflo(w.z), bfhi(w.z), bflo(w.w), bfhi(w.w)}; }
    } else {
#pragma unroll
        for (int j = 0; j < 8; ++j) f[j] = *(const f32x4*)(fs + LN_COL(lane, j));
        for (int ks = 1; ks < nks; ++ks) {
#pragma unroll
            for (int j = 0; j < 8; ++j) f[j] += *(const f32x4*)(fs + (size_t)ks * RC * D + LN_COL(lane, j)); }
    }
}
__device__ __forceinline__ void ln_finish(f32x4 (&x)[8], const f32x4 (&f)[8], const LAS float* Tv, const LAS float* Tg, int lane, float* xo, _Float16* xho, bf16* ao) {
    float sum = 0.f;
#pragma unroll
    for (int j = 0; j < 8; ++j) { const int col = LN_COL(lane, j); const f32x4 gg = *(const LAS f32x4*)(Tv + col), bb = *(const LAS f32x4*)(Tv + D + col);
        x[j] = ALPHA * x[j] + (gg * f[j] + bb); sum += (x[j][0] + x[j][1]) + (x[j][2] + x[j][3]); if (j & 1) asm volatile("" ::: "memory"); }
    const float mean = wave_sum(sum) * (1.0f / D); float s2 = 0.f;
#pragma unroll
    for (int j = 0; j < 8; ++j) { x[j] = x[j] - mean; s2 += (x[j][0] * x[j][0] + x[j][1] * x[j][1]) + (x[j][2] * x[j][2] + x[j][3] * x[j][3]); }
    const float rstd = 1.0f / sqrtf(wave_sum(s2) * (1.0f / D) + LN_EPS);
#pragma unroll
    for (int q = 0; q < 4; ++q) { const int col = LN_COL(lane, 2 * q); const f32x4 n0 = x[2 * q] * rstd, n1 = x[2 * q + 1] * rstd;
        const f32x4 y0 = n0 * *(const LAS f32x4*)(Tg + col) + *(const LAS f32x4*)(Tg + D + col), y1 = n1 * *(const LAS f32x4*)(Tg + col + 4) + *(const LAS f32x4*)(Tg + D + col + 4);
        if (xo) { *(f32x4*)(xo + col) = y0; *(f32x4*)(xo + col + 4) = y1; }
        else *(f16x8*)(xho + col) = (f16x8){(_Float16)y0[0], (_Float16)y0[1], (_Float16)y0[2], (_Float16)y0[3], (_Float16)y1[0], (_Float16)y1[1], (_Float16)y1[2], (_Float16)y1[3]};
        if (ao) { const f32x4 a0 = n0 * *(const LAS f32x4*)(Tv + 2 * D + col) + *(const LAS f32x4*)(Tv + 3 * D + col), a1 = n1 * *(const LAS f32x4*)(Tv + 2 * D + col + 4) + *(const LAS f32x4*)(Tv + 3 * D + col + 4);
            v4u o; o.x = pk2(a0[0], a0[1]); o.y = pk2(a0[2], a0[3]); o.z = pk2(a1[0], a1[1]); o.w = pk2(a1[2], a1[3]); *(v4u*)(ao + col) = o; }
        asm volatile("" ::: "memory"); }
}
__device__ __forceinline__ void ln_phase(Frame& F, int l, int s, bool dummy = false) {
    fresh(F);
    const bool last = (l == DEPTH - 1 && s == 2), first = (l == 0 && s == 0);
    const float gsc = (s == 1) ? 1.0f : 0.5f;
    const float* bias = (s == 1) ? F.in[I_BOUT] + (size_t)l * D : nullptr;
    const float* lg = F.in[I_LNG] + (size_t)(l * 3 + s) * D; const float* lb = F.in[I_LNB] + (size_t)(l * 3 + s) * D;
    const float* modl = F.MOD + (size_t)l * 3 * NADA;
    const float* modn = (s == 2) ? F.MOD + (size_t)(last ? l : l + 1) * 3 * NADA : modl;
    const int shi = (s == 2) ? 0 : 3 * s + 3;
    const int nrows = last ? RL : R;
    const int nks = (s == 1) ? KS_WOUT : KS_FFN;
    LAS float* T = (LAS float*)(F.lds + RING_OFF);
#pragma unroll
    for (int i = F.tid; i < 3 * D; i += NWAVES * 64) { const int v = i >> 11, col = i & (D - 1);
        const float gg = gsc * modl[(size_t)v * NADA + (3 * s + 2) * D + col], lgv = lg[col], lbv = lb[col];
        const float sh = modn[(size_t)v * NADA + shi * D + col], sc = modn[(size_t)v * NADA + (shi + 1) * D + col];
        T[(v * 4 + 0) * D + col] = gg; T[(v * 4 + 1) * D + col] = bias ? gg * bias[col] : 0.f; T[(v * 4 + 2) * D + col] = lgv * (1.0f + sc); T[(v * 4 + 3) * D + col] = lbv * (1.0f + sc) + sh;
        if (v == 0) { T[12 * D + col] = lgv; T[13 * D + col] = lbv; } }
    __syncthreads();
    const LAS float* Tg = T + 12 * D;
    const int l_begin = (int)((long)RL * blockIdx.x / F.G), l_end = (int)((long)RL * (blockIdx.x + 1) / F.G);
    const int c_begin = (int)((long)RC * blockIdx.x / F.G), nc = (l == DEPTH - 1 && s >= 1) ? 0 : (int)((long)RC * (blockIdx.x + 1) / F.G) - c_begin,     ntot = nc + (l_end - l_begin);
    LAS unsigned* ctr = (LAS unsigned*)(F.lds + MISC_OFF) + 16;
#define LN_GRAB(k_) do { unsigned g_ = 0u; if (F.lane == 0) g_ = __hip_atomic_fetch_add(ctr, 1u, __ATOMIC_RELAXED, __HIP_MEMORY_SCOPE_WORKGROUP); k_ = __builtin_amdgcn_readfirstlane((int)g_); } while (0)
#define LN_ROW(k_) ((k_) < nc ? RL + c_begin + (k_) : l_begin + ((k_) - nc))
#define LN_SRC(row, xin, fin, nk) const float* xin = first ? ((row) < RL ? F.in[I_X] + (size_t)(row) * D : F.in[I_CTX] + (size_t)((row) - RL) * D) : nullptr; const _Float16* xh = F.XS + (size_t)(row) * D; \
        const bf16* fb = F.Fb + (size_t)((row) < RL ? (row) : 0) * D; const float* fin = F.SLAB + (size_t)((row) < RL ? 0 : (row) - RL) * D; const int nk = (row) < RL ? 0 : nks;
#define LN_DST(row, Tv, xo, ao) const LAS float* Tv = T + ((row) < RL ? ((row) >> 13) : 2) * 4 * D; float* xo = last ? (dummy ? (float*)F.HID : F.out) + (size_t)(row) * D : nullptr; _Float16* xho = (dummy ? (_Float16*)F.HID : F.XS) + (size_t)(row) * D; bf16* ao = dummy ? F.Y + (size_t)(row) * D : last ? nullptr : F.A + (size_t)(row) * D;
    {
        f32x4 xa[8], fa[8], xb[8], fb_[8];
        int ka, kb; LN_GRAB(ka);
        if (ka < ntot) { const int rA = LN_ROW(ka); LN_SRC(rA, xin, fin, nk) ln_load(xin, xh, fb, fin, nk, F.lane, xa, fa); }
        while (ka < ntot) {
            LN_GRAB(kb);
            if (kb < ntot) { const int rB = LN_ROW(kb); LN_SRC(rB, xin, fin, nk) ln_load(xin, xh, fb, fin, nk, F.lane, xb, fb_); }
            asm volatile("" ::: "memory");
            { const int rA = LN_ROW(ka); LN_DST(rA, Tv, xo, ao) ln_finish(xa, fa, Tv, Tg, F.lane, xo, xho, ao); }
            asm volatile("" ::: "memory");
            if (kb >= ntot) break;
            LN_GRAB(ka);
            if (ka < ntot) { const int rA = LN_ROW(ka); LN_SRC(rA, xin, fin, nk) ln_load(xin, xh, fb, fin, nk, F.lane, xa, fa); }
            asm volatile("" ::: "memory");
            { const int rB = LN_ROW(kb); LN_DST(rB, Tv, xo, ao) ln_finish(xb, fb_, Tv, Tg, F.lane, xo, xho, ao); }
            asm volatile("" ::: "memory");
        }
    }
#undef LN_GRAB
#undef LN_ROW
#undef LN_SRC
#undef LN_DST
    __syncthreads();
    if (F.tid == 0) *ctr = 0u;
}
constexpr int CT = 16;
__device__ __forceinline__ void conv4_phase(Frame& F, int l) {
    fresh(F);
    {
        const float* w4 = F.in[I_C4W] + (size_t)l * 4 * DLRU; const float* b4 = F.in[I_C4B] + (size_t)l * DLRU;
        for (int idx = blockIdx.x * (NWAVES * 64) + F.tid; idx < R * (DLRU / 8); idx += F.G * NWAVES * 64) {
            const int row = idx >> 7, c8 = (idx & 127) * 8;
            int s0, s1; if (row < RL) { s0 = row & ~(SEQ - 1); s1 = s0 + SEQ; } else { s0 = RL + ((row - RL) & ~(CTXL - 1)); s1 = s0 + CTXL; }
            f32x4 a0 = *(const f32x4*)(b4 + c8), a1 = *(const f32x4*)(b4 + c8 + 4);
#pragma unroll
            for (int k = 0; k < 4; ++k) { const int rr = row + k - 2;
                if (rr >= s0 && rr < s1) { const f32x4 w0 = *(const f32x4*)(w4 + k * DLRU + c8), w1 = *(const f32x4*)(w4 + k * DLRU + c8 + 4); f32x4 x0, x1;
                    if (row < RL) { const v4u xv = *(const v4u*)(F.P + (size_t)rr * PLD + c8); x0 = (f32x4){bflo(xv.x), bfhi(xv.x), bflo(xv.y), bfhi(xv.y)}; x1 = (f32x4){bflo(xv.z), bfhi(xv.z), bflo(xv.w), bfhi(xv.w)}; }
                    else { const float* sp = F.PSLAB + (size_t)(rr - RL) * DIN + c8; x0 = *(const f32x4*)sp; x1 = *(const f32x4*)(sp + 4);
#pragma unroll
                        for (int ks = 1; ks < KS_MIX; ++ks) { x0 += *(const f32x4*)(sp + (size_t)ks * RC * DIN); x1 += *(const f32x4*)(sp + (size_t)ks * RC * DIN + 4); } }
                    a0 += w0 * x0; a1 += w1 * x1; } }
            v4u o; o.x = pk2(a0[0], a0[1]); o.y = pk2(a0[2], a0[3]); o.z = pk2(a1[0], a1[1]); o.w = pk2(a1[2], a1[3]);
            *(v4u*)(F.XC + (size_t)row * DLRU + c8) = o;
        }
    }
    if (l != DEPTH - 1) {
        for (int idx = blockIdx.x * (NWAVES * 64) + F.tid; idx < RC * 256; idx += F.G * NWAVES * 64) {
            const int rc = idx >> 8, j8 = (idx & 127) * 8; const bool glu = (idx & 128) != 0;
            const int cv_col = glu ? 2 * DLRU + 256 * (j8 >> 7) + (j8 & 127) : DLRU + j8;
            const float* sp = F.PSLAB + (size_t)rc * DIN + cv_col; f32x4 x0 = *(const f32x4*)sp, x1 = *(const f32x4*)(sp + 4), g0 = {0.f, 0.f, 0.f, 0.f}, g1 = g0;
            if (glu) { g0 = *(const f32x4*)(sp + 128); g1 = *(const f32x4*)(sp + 132); }
#pragma unroll
            for (int ks = 1; ks < KS_MIX; ++ks) { const float* sq = sp + (size_t)ks * RC * DIN; x0 += *(const f32x4*)sq; x1 += *(const f32x4*)(sq + 4); if (glu) { g0 += *(const f32x4*)(sq + 128); g1 += *(const f32x4*)(sq + 132); } }
            if (glu) {
#pragma unroll
                for (int e = 0; e < 4; ++e) { x0[e] *= sigm(g0[e]); x1[e] *= sigm(g1[e]); } }
            v4u o; o.x = pk2(x0[0], x0[1]); o.y = pk2(x0[2], x0[3]); o.z = pk2(x1[0], x1[1]); o.w = pk2(x1[2], x1[3]);
            if (glu) *(v4u*)(F.U + (size_t)(RL + rc) * DCONV + j8) = o; else *(v4u*)(F.P + (size_t)(RL + rc) * PLD + DLRU + j8) = o;
        }
    }
}
__device__ __forceinline__ void conv31_phase(Frame& F, int l) {
    fresh(F);
    {
        const float* w31 = F.in[I_C31W] + (size_t)l * CONVK * DCONV; const float* b31 = F.in[I_C31B] + (size_t)l * DCONV;
        const float* cg_ = F.in[I_CLNG] + (size_t)l * DCONV; const float* cb_ = F.in[I_CLNB] + (size_t)l * DCONV;
        LAS f32x2* red = (LAS f32x2*)(F.lds + RING_OFF);
        LAS f32x2* stat = (LAS f32x2*)(F.lds + RING_OFF + 4096);
        const int cp = F.tid;
        f32x2 w[CONVK];
#pragma unroll
        for (int k = 0; k < CONVK; ++k) w[k] = *(const f32x2*)(w31 + k * DCONV + 2 * cp);
        const f32x2 bb = *(const f32x2*)(b31 + 2 * cp), lng = *(const f32x2*)(cg_ + 2 * cp), lnb = *(const f32x2*)(cb_ + 2 * cp);
        const int nitems = ((l == DEPTH - 1) ? RL : R) / CT;
        LAS int* itl = (LAS int*)(F.lds + MISC_OFF) + 20;
        for (;;) {
            if (F.tid == 0) *itl = (int)__hip_atomic_fetch_add(F.ctl + CW_Q + 64 * l, 1u, __ATOMIC_RELAXED, __HIP_MEMORY_SCOPE_AGENT);
            __syncthreads();
            const int it = *itl;
            if (it >= nitems) break;
            const int row0 = it * CT;
            int g0, g1; if (row0 < RL) { g0 = row0 & ~(GRIDW - 1); g1 = g0 + GRIDW; } else { g0 = RL + ((row0 - RL) & ~(CTXL - 1)); g1 = g0 + CTXL; }
            constexpr int CCH = 8, NTK = CT + CONVK - 1, NCH = (NTK + CCH - 1) / CCH;
            unsigned cva[CCH], cvb[CCH];
#define CV_LOAD(cv_, c_) do { _Pragma("unroll") for (int q = 0; q < CCH; ++q) { const int ti = (c_) * CCH + q; if (ti < NTK) { const int tok = row0 - (CONVK / 2) + ti; const int tc = (tok >= g0 && tok < g1) ? tok : row0; \
                cv_[q] = *(const unsigned*)(F.U + (size_t)tc * DCONV + 2 * cp); } } } while (0)
#define CV_USE(cv_, c_) do { _Pragma("unroll") for (int q = 0; q < CCH; ++q) { const int ti = (c_) * CCH + q; if (ti < NTK) { const int tok = row0 - (CONVK / 2) + ti; const bool ok = (tok >= g0 && tok < g1); \
                f32x2 u; u.x = ok ? bflo(cv_[q]) : 0.f; u.y = ok ? bfhi(cv_[q]) : 0.f; \
                _Pragma("unroll") for (int k = 0; k < CONVK; ++k) { const int to = ti - k; if (to >= 0 && to < CT) acc[to] += w[k] * u; } } } } while (0)
            f32x2 acc[CT];
#pragma unroll
            for (int j = 0; j < CT; ++j) acc[j] = bb;
            CV_LOAD(cva, 0);
#pragma unroll
            for (int c = 0; c < NCH; c += 2) {
                if (c + 1 < NCH) CV_LOAD(cvb, c + 1);
                CV_USE(cva, c);
                if (c + 2 < NCH) CV_LOAD(cva, c + 2);
                if (c + 1 < NCH) CV_USE(cvb, c + 1);
            }
#undef CV_LOAD
#undef CV_USE
#pragma unroll
            for (int j = 0; j < CT; ++j) { const float s1 = wave_sum(acc[j].x + acc[j].y), s2 = wave_sum(acc[j].x * acc[j].x + acc[j].y * acc[j].y);
                if (F.lane == 0) red[F.wave * CT + j] = (f32x2){s1, s2}; }
            __syncthreads();
            if (F.tid < CT) { float s1 = 0.f, s2 = 0.f;
#pragma unroll
                for (int wv = 0; wv < NWAVES; ++wv) { const f32x2 r = red[wv * CT + F.tid]; s1 += r.x; s2 += r.y; }
                const float mean = s1 * (1.0f / DCONV), var = fmaxf(s2 * (1.0f / DCONV) - mean * mean, 0.f);
                stat[F.tid] = (f32x2){mean, 1.0f / sqrtf(var + LN_EPS)}; }
            __syncthreads();
#pragma unroll
            for (int j = 0; j < CT; ++j) { const f32x2 st = stat[j];
                const float y0 = (acc[j].x - st.x) * st.y * lng.x + lnb.x, y1 = (acc[j].y - st.x) * st.y * lng.y + lnb.y;
                *(unsigned*)(F.Y + (size_t)(row0 + j) * D + DLRU + 2 * cp) = pk2(y0 * sigm(y0), y1 * sigm(y1)); }
            __syncthreads();
        }
    }
}
__device__ __forceinline__ void scan1_phase(Frame& F, int l) {
    fresh(F);
    const int cp = F.tid;
    for (int it = blockIdx.x; it < NSUB * 2; it += F.G) {
        const int sc = it >> 1, d = it & 1, r0 = sc * SUBL;
        unsigned aw[SUBL], bw[SUBL];
#pragma unroll
        for (int j = 0; j < SUBL; ++j) { const int row = d ? r0 + SUBL - 1 - j : r0 + j;
            aw[j] = *(const unsigned*)(F.GT + (size_t)row * 4096 + (2 * d) * 1024 + 2 * cp); bw[j] = *(const unsigned*)(F.GT + (size_t)row * 4096 + (2 * d + 1) * 1024 + 2 * cp); }
        float A0 = 1.f, A1 = 1.f, B0 = 0.f, B1 = 0.f;
#pragma unroll
        for (int j = 0; j < SUBL; ++j) {
            const float a0 = __builtin_amdgcn_exp2f(bflo(aw[j])), a1 = __builtin_amdgcn_exp2f(bfhi(aw[j]));
            A0 *= a0; B0 = a0 * B0 + bflo(bw[j]); A1 *= a1; B1 = a1 * B1 + bfhi(bw[j]); }
        *(f32x2*)(F.SA + (size_t)(sc * 2 + d) * DLRU + 2 * cp) = (f32x2){A0, A1};
        *(f32x2*)(F.SB + (size_t)(sc * 2 + d) * DLRU + 2 * cp) = (f32x2){B0, B1};
    }
}
__device__ __forceinline__ void scan2_phase(Frame& F) {
    fresh(F);
    if (blockIdx.x < 64 && F.tid < 64) {
        const int gt = blockIdx.x * 64 + F.tid, c = gt & 1023, d = (gt >> 10) & 1, b = gt >> 11;
        const float* __restrict__ SA = F.SA; const float* __restrict__ SB = F.SB; float* __restrict__ HIN = F.HIN;
        float carry = 0.f;
        constexpr int NCS = CTXL / SUBL, NLS = SEQ / SUBL;
#pragma unroll
        for (int q = 0; q < NCS; ++q) { const int sc = RL / SUBL + NCS * b + (d ? NCS - 1 - q : q); const size_t ix = (size_t)(sc * 2 + d) * DLRU + c; HIN[ix] = carry; carry = SA[ix] * carry + SB[ix]; }
        for (int q0 = 0; q0 < NLS; q0 += 32) { float sa[32], sb[32];
#pragma unroll
            for (int q = 0; q < 32; ++q) { const int sc = NLS * b + (d ? NLS - 1 - (q0 + q) : q0 + q); const size_t ix = (size_t)(sc * 2 + d) * DLRU + c; sa[q] = SA[ix]; sb[q] = SB[ix]; }
#pragma unroll
            for (int q = 0; q < 32; ++q) { const int sc = NLS * b + (d ? NLS - 1 - (q0 + q) : q0 + q); const size_t ix = (size_t)(sc * 2 + d) * DLRU + c; HIN[ix] = carry; carry = sa[q] * carry + sb[q]; } }
    }
}
__device__ __forceinline__ float gelu_tanh(float x) { return x * sigm(1.5957691216057308f * (x + 0.044715f * x * x * x)); }
__device__ __forceinline__ void scan3_phase(Frame& F, int l) {
    fresh(F);
    const int cp = F.tid;
    for (int sc = blockIdx.x; sc < ((l == DEPTH - 1) ? RL / SUBL : NSUB); sc += F.G) {
        const int r0 = sc * SUBL;
        unsigned af[SUBL], bf_[SUBL], ab[SUBL], bb_[SUBL], gw_[SUBL];
#pragma unroll
        for (int j = 0; j < SUBL; ++j) { const bf16* g = F.GT + (size_t)(r0 + j) * 4096 + 2 * cp;
            af[j] = *(const unsigned*)g; bf_[j] = *(const unsigned*)(g + 1024); ab[j] = *(const unsigned*)(g + 2048); bb_[j] = *(const unsigned*)(g + 3072);
            gw_[j] = *(const unsigned*)(F.P + (size_t)(r0 + j) * PLD + DLRU + 2 * cp); }
        f32x2 h = *(const f32x2*)(F.HIN + (size_t)(sc * 2 + 0) * DLRU + 2 * cp);
        LAS f32x2* hfl = (LAS f32x2*)(F.lds + RING_OFF) + cp;
#pragma unroll
        for (int j = 0; j < SUBL; ++j) {
            h.x = __builtin_amdgcn_exp2f(bflo(af[j])) * h.x + bflo(bf_[j]); h.y = __builtin_amdgcn_exp2f(bfhi(af[j])) * h.y + bfhi(bf_[j]); hfl[j * (NWAVES * 64)] = h; }
        h = *(const f32x2*)(F.HIN + (size_t)(sc * 2 + 1) * DLRU + 2 * cp);
#pragma unroll
        for (int j = SUBL - 1; j >= 0; --j) { const int row = r0 + j;
            h.x = __builtin_amdgcn_exp2f(bflo(ab[j])) * h.x + bflo(bb_[j]); h.y = __builtin_amdgcn_exp2f(bfhi(ab[j])) * h.y + bfhi(bb_[j]);
            const f32x2 hf = hfl[j * (NWAVES * 64)];
            *(unsigned*)(F.Y + (size_t)row * D + 2 * cp) = pk2((hf.x + h.x) * gelu_tanh(bflo(gw_[j])), (hf.y + h.y) * gelu_tanh(bfhi(gw_[j]))); }
    }
}

struct Args { const float* in[N_IN]; float* out; unsigned char* ws; int ph_lo, ph_hi; };
static_assert(sizeof(Args) == N_IN * 8 + 8 + 8 + 8, "Args has no padding");
__global__ void __launch_bounds__(NWAVES * 64, 2) mk_fwd(Args args) {
    extern __shared__ __attribute__((aligned(16))) unsigned char lds[];
    Frame F;
    F.lds = (LAS unsigned char*)lds;
    F.tid = threadIdx.x; F.lane = F.tid & 63; F.wave = __builtin_amdgcn_readfirstlane(F.tid >> 6); F.G = gridDim.x;
#pragma unroll
    for (int i = 0; i < N_IN; ++i) F.in[i] = args.in[i];
    F.out = args.out;
    unsigned char* ws = args.ws;
    gu32* ctl = (gu32*)(ws + WS_CTL); F.ctl = ctl;
    F.MOD = (float*)(ws + WS_MOD); F.SA = (float*)(ws + WS_SA); F.SB = (float*)(ws + WS_SB); F.HIN = (float*)(ws + WS_HIN);
    F.W1T = (bf16*)(ws + WS_W1T); F.W2T = (bf16*)(ws + WS_W2T); F.WINT = (bf16*)(ws + WS_WINT); F.WOUTT = (bf16*)(ws + WS_WOUTT); F.WGT = (bf16*)(ws + WS_WGT);
    F.XS = (_Float16*)(ws + WS_XS); F.A = (bf16*)(ws + WS_A); F.Fb = (bf16*)(ws + WS_F); F.P = (bf16*)(ws + WS_F); F.HID = (bf16*)(ws + WS_HID);
    F.GT = (bf16*)(ws + WS_HID); F.XC = (bf16*)(ws + WS_HID + 132 * MiB); F.Y = (bf16*)(ws + WS_Y); F.SLAB = (float*)(ws + WS_SLAB); F.PSLAB = (float*)(ws + WS_PSLAB); F.U = (bf16*)(ws + WS_F + 66 * MiB); F.K8 = (float*)(ws + WS_MOD + 768 * 1024);
    for (int u = F.tid; u < (LDS_BYTES - LDSCTL_OFF) / 4; u += NWAVES * 64) ((LAS unsigned*)(F.lds + LDSCTL_OFF))[u] = 0u;
    __syncthreads();
    const int lo = args.ph_lo, hi = args.ph_hi;
    XcdBarrier bar; bar.bar = (unsigned*)(ctl + CW_BAR); bar.x = 0; bar.st = nullptr;
    if (hi - lo > 1) bar = xcd_barrier_post((unsigned*)(ctl + CW_BAR), (volatile LAS unsigned*)(F.lds + MISC_OFF) + 8);
#define PH(k) (lo <= (k) && (k) < hi)
#ifndef DUP_MASK
#define DUP_MASK 0
#endif
#define NREP(j) (1 + ((DUP_MASK >> (j)) & 1))
#ifndef DUP_BAR
#define DUP_BAR 0
#endif
#define SEAM(k) do { if ((k) + 1 < hi) { xcd_barrier(bar); if (DUP_BAR) xcd_barrier(bar); } } while (0)

    if (PH(0)) for (int rep_ = 0; rep_ < NREP(14); ++rep_) { prologue_a(F); SEAM(0); }
    if (PH(1)) { init_phase(F); SEAM(1); }
#pragma unroll 1
    for (int l = 0; l < DEPTH; ++l) {
        const int pb = 2 + 14 * l;
        if (PH(pb + 0)) for (int rep_ = 0; rep_ < NREP(0); ++rep_) {
            pg8::Gemm g{F.A, F.W1T + (size_t)(l * 2 + 0) * NFF * D, R, NFF, D, D, D, 0, 0}; pg8::StaticOrder S; S.init(R, NFF, F.G, (int)blockIdx.x);
            pg8::EpiSwiGLU E{F.HID, DFF};
            pg8::gemm_phase<pg8::EpiSwiGLU, pg8::StaticOrder, true, true>(F.lds + RING_OFF, g, S, E);
            if (rep_ == 0) { if (l + 1 < DEPTH) convert_in_tail(F, l + 1, 0, CV_S1, (R / 256) * (NFF / 256)); if (l > 0) convert_in_tail(F, l, CV_S2, CV_LAYER_ITEMS, (R / 256) * (NFF / 256)); }
            SEAM(pb + 0);
        }
        if (PH(pb + 1)) for (int rep_ = 0; rep_ < NREP(1); ++rep_) {
            { pg8::Gemm g{F.HID, F.W2T + (size_t)(l * 2 + 0) * D * DFF, RL, D, DFF, DFF, DFF, 0, 0}; pg8::StaticOrder S; S.init(RL, D, F.G, (int)blockIdx.x);
              pg8::EpiBf16P E{F.Fb, D};
              pg8::gemm_phase<pg8::EpiBf16P, pg8::StaticOrder, true, true>(F.lds + RING_OFF, g, S, E); }
            { int kc = DFF / KS_FFN; asm volatile("" : "+s"(kc));
              pg8::Gemm g{F.HID, F.W2T + (size_t)(l * 2 + 0) * D * DFF, R, D, kc, DFF, DFF, 2 * (DFF / KS_FFN), 2 * (DFF / KS_FFN)}; pg8::SplitKOrder S{RL / 256, RC / 256, D / 256, KS_FFN, F.G, (int)blockIdx.x};
              pg8::EpiF32 E{F.SLAB, D, RL / 256, (size_t)RC * D};
              pg8::gemm_phase<pg8::EpiF32, pg8::SplitKOrder, true, true>(F.lds + RING_OFF, g, S, E); }
            SEAM(pb + 1);
        }
        if (PH(pb + 2)) { if (NREP(2) > 1) { ln_phase(F, l, 0, true); xcd_barrier(bar); } ln_phase(F, l, 0); SEAM(pb + 2); }
        if (PH(pb + 3)) for (int rep_ = 0; rep_ < NREP(3); ++rep_) {
            { pg8::Gemm g{F.A, F.WINT + (size_t)l * DIN * D, RL, DIN, D, D, D, 0, 0}; pg8::StaticOrder S; S.init(RL, DIN, F.G, (int)blockIdx.x);
              pg8::EpiMixIn E{F.P, F.U};
              pg8::gemm_phase<pg8::EpiMixIn, pg8::StaticOrder, true, true>(F.lds + RING_OFF, g, S, E); }
            { int kc = D / KS_MIX; asm volatile("" : "+s"(kc));
              pg8::Gemm g{F.A, F.WINT + (size_t)l * DIN * D, R, DIN, kc, D, D, 2 * (D / KS_MIX), 2 * (D / KS_MIX)}; pg8::SplitKOrder S{RL / 256, RC / 256, (l == DEPTH - 1) ? DLRU / 256 : DIN / 256, KS_MIX, F.G, (int)blockIdx.x};
              pg8::EpiF32 E{F.PSLAB, DIN, RL / 256, (size_t)RC * DIN};
              pg8::gemm_phase<pg8::EpiF32, pg8::SplitKOrder, true, true>(F.lds + RING_OFF, g, S, E); }
            SEAM(pb + 3);
        }
        if (PH(pb + 4)) for (int rep_ = 0; rep_ < NREP(4); ++rep_) { conv4_phase(F, l); SEAM(pb + 4); }
        if (PH(pb + 5)) for (int rep_ = 0; rep_ < NREP(5); ++rep_) {
            int kg = 256; asm volatile("" : "+s"(kg));
            pg8::Gemm g{F.XC, F.WGT + (size_t)l * 4096 * 256, R, 4096, kg, DLRU, 256, 512, 0}; pg8::StaticOrder S; S.init(R, 4096, F.G, (int)blockIdx.x, 2);
            pg8::EpiGates E{F.GT, F.in[I_BRG] + (size_t)l * 2 * DLRU, F.in[I_BIG] + (size_t)l * 2 * DLRU, F.K8 + (size_t)l * 2 * DLRU, F.XC};
            pg8::gemm_phase<pg8::EpiGates, pg8::StaticOrder, true, true>(F.lds + RING_OFF, g, S, E);
            SEAM(pb + 5);
        }
        if (PH(pb + 6)) for (int rep_ = 0; rep_ < NREP(6); ++rep_) { scan1_phase(F, l); SEAM(pb + 6); }
        if (PH(pb + 7)) for (int rep_ = 0; rep_ < NREP(7); ++rep_) { scan2_phase(F); conv31_phase(F, l); SEAM(pb + 7); }
        if (PH(pb + 8)) for (int rep_ = 0; rep_ < NREP(8); ++rep_) { scan3_phase(F, l); SEAM(pb + 8); }
        if (PH(pb + 9)) for (int rep_ = 0; rep_ < NREP(9); ++rep_) {
            { pg8::Gemm g{F.Y, F.WOUTT + (size_t)l * D * D, RL, D, D, D, D, 0, 0}; pg8::StaticOrder S; S.init(RL, D, F.G, (int)blockIdx.x);
              pg8::EpiBf16P E{F.Fb, D};
              pg8::gemm_phase<pg8::EpiBf16P, pg8::StaticOrder, true, true>(F.lds + RING_OFF, g, S, E); }
            if (l != DEPTH - 1) { int kc = D / KS_WOUT; asm volatile("" : "+s"(kc));
              pg8::Gemm g{F.Y, F.WOUTT + (size_t)l * D * D, R, D, kc, D, D, 2 * (D / KS_WOUT), 2 * (D / KS_WOUT)}; pg8::SplitKOrder S{RL / 256, RC / 256, D / 256, KS_WOUT, F.G, (int)blockIdx.x};
              pg8::EpiF32 E{F.SLAB, D, RL / 256, (size_t)RC * D};
              pg8::gemm_phase<pg8::EpiF32, pg8::SplitKOrder, true, true>(F.lds + RING_OFF, g, S, E); }
            SEAM(pb + 9);
        }
        if (PH(pb + 10)) { if (NREP(10) > 1) { ln_phase(F, l, 1, true); xcd_barrier(bar); } ln_phase(F, l, 1); SEAM(pb + 10); }
        if (PH(pb + 11)) for (int rep_ = 0; rep_ < NREP(11); ++rep_) {
            const int mrows = (l == DEPTH - 1) ? RL : R;
            pg8::Gemm g{F.A, F.W1T + (size_t)(l * 2 + 1) * NFF * D, mrows, NFF, D, D, D, 0, 0}; pg8::StaticOrder S; S.init(mrows, NFF, F.G, (int)blockIdx.x);
            pg8::EpiSwiGLU E{F.HID, DFF};
            pg8::gemm_phase<pg8::EpiSwiGLU, pg8::StaticOrder, true, true>(F.lds + RING_OFF, g, S, E);
            if (l + 1 < DEPTH && rep_ == 0) convert_in_tail(F, l + 1, CV_S1, CV_S2, (mrows / 256) * (NFF / 256));
            SEAM(pb + 11);
        }
        if (PH(pb + 12)) for (int rep_ = 0; rep_ < NREP(12); ++rep_) {
            { pg8::Gemm g{F.HID, F.W2T + (size_t)(l * 2 + 1) * D * DFF, RL, D, DFF, DFF, DFF, 0, 0}; pg8::StaticOrder S; S.init(RL, D, F.G, (int)blockIdx.x);
              pg8::EpiBf16P E{F.Fb, D};
              pg8::gemm_phase<pg8::EpiBf16P, pg8::StaticOrder, true, true>(F.lds + RING_OFF, g, S, E); }
            if (l != DEPTH - 1) { int kc = DFF / KS_FFN; asm volatile("" : "+s"(kc));
              pg8::Gemm g{F.HID, F.W2T + (size_t)(l * 2 + 1) * D * DFF, R, D, kc, DFF, DFF, 2 * (DFF / KS_FFN), 2 * (DFF / KS_FFN)}; pg8::SplitKOrder S{RL / 256, RC / 256, D / 256, KS_FFN, F.G, (int)blockIdx.x};
              pg8::EpiF32 E{F.SLAB, D, RL / 256, (size_t)RC * D};
              pg8::gemm_phase<pg8::EpiF32, pg8::SplitKOrder, true, true>(F.lds + RING_OFF, g, S, E); }
            SEAM(pb + 12);
        }
        if (PH(pb + 13)) { if (NREP(13) > 1) { ln_phase(F, l, 2, true); xcd_barrier(bar); } ln_phase(F, l, 2); SEAM(pb + 13); }
    }
#if defined(DBG_DUMP)
    if (PH(N_PHASES)) {
        for (size_t i = (size_t)blockIdx.x * (NWAVES * 64) + threadIdx.x; i < (size_t)RL * D; i += (size_t)F.G * NWAVES * 64) {
            float v;
            if (DBG_DUMP == 0) v = (float)F.XS[i]; else if (DBG_DUMP == 1) v = bflo(F.Fb[i]); else if (DBG_DUMP == 2) v = bflo(F.A[i]); else if (DBG_DUMP == 3) v = bflo(F.Y[i]);
            else if (DBG_DUMP == 4) v = bflo(F.HID[i]); else if (DBG_DUMP == 5) v = bflo(F.P[i]); else if (DBG_DUMP == 6) v = bflo(F.GT[i]); else if (DBG_DUMP == 7) v = bflo(F.XC[i % ((size_t)R * DLRU)]);
            else if (DBG_DUMP == 8) v = F.MOD[i % ((size_t)DEPTH * 3 * NADA)]; else v = F.SA[i % ((size_t)3 * 5 * 262144)];
            F.out[i] = v; }
    }
#endif
    if (hi == N_PHASES && blockIdx.x == 0 && F.tid == 0) {
        if (__hip_atomic_load(ctl + CW_BAR + XB_TMO, RLX_AGENT) != 0u) F.out[0] = __builtin_nanf("");
    }
#undef PH
#undef SEAM
}

extern "C" void kernel_launch(void* const* d_in, const int* in_sizes, int n_in, void* d_out, int out_size, void* d_ws, size_t ws_size, hipStream_t stream) {
    static int grid = 0;
    if (grid == 0) {
        if (n_in != N_IN || in_sizes[0] != RL * D || out_size != RL * D || ws_size < WS_END) { fprintf(stderr, "kernel_launch: unexpected shapes (n_in %d, in0 %d, out %d, ws %zu); nothing launched\n", n_in, n_in > 0 ? in_sizes[0] : -1, out_size, ws_size); grid = -1; return; }
        int dev = 0, cus = 0, per_cu = 0;
        if (hipGetDevice(&dev) != hipSuccess || hipDeviceGetAttribute(&cus, hipDeviceAttributeMultiprocessorCount, dev) != hipSuccess) { fprintf(stderr, "kernel_launch: device query failed\n"); grid = -1; return; }
        if (hipFuncSetAttribute((const void*)mk_fwd, hipFuncAttributeMaxDynamicSharedMemorySize, LDS_BYTES) != hipSuccess) { fprintf(stderr, "kernel_launch: hipFuncSetAttribute failed\n"); grid = -1; return; }
        if (hipOccupancyMaxActiveBlocksPerMultiprocessor(&per_cu, (const void*)mk_fwd, NWAVES * 64, LDS_BYTES) != hipSuccess || per_cu < 1) fprintf(stderr, "kernel_launch: note: occupancy query reports %d workgroups per CU\n", per_cu);
        (void)hipGetLastError();
        grid = cus;
    }
    if (grid < 0) return;
    if (hipMemsetAsync((char*)d_ws + WS_CTL, 0, CTL_ZERO_BYTES, stream) != hipSuccess) { fprintf(stderr, "kernel_launch: memset failed\n"); return; }
    Args a{};
    for (int i = 0; i < N_IN; ++i) a.in[i] = (const float*)d_in[i];
    a.out = (float*)d_out; a.ws = (unsigned char*)d_ws;
#if defined(DBG_DUMP)
    for (int p = 0; p < DBG_STOP; ++p) { a.ph_lo = p; a.ph_hi = p + 1; hipLaunchKernelGGL(mk_fwd, dim3(grid), dim3(NWAVES * 64), LDS_BYTES, stream, a); }
    a.ph_lo = N_PHASES; a.ph_hi = N_PHASES + 1; hipLaunchKernelGGL(mk_fwd, dim3(grid), dim3(NWAVES * 64), LDS_BYTES, stream, a);
#elif MK_PER_PHASE
    for (int p = 0; p < N_PHASES; ++p) { a.ph_lo = p; a.ph_hi = p + 1; hipLaunchKernelGGL(mk_fwd, dim3(grid), dim3(NWAVES * 64), LDS_BYTES, stream, a); }
#else
    a.ph_lo = 0; a.ph_hi = N_PHASES;
    hipLaunchKernelGGL(mk_fwd, dim3(grid), dim3(NWAVES * 64), LDS_BYTES, stream, a);
#endif
    const hipError_t le = hipPeekAtLastError();
    if (le != hipSuccess) fprintf(stderr, "kernel_launch: launch failed: %s\n", hipGetErrorName(le));
}
```

```cpp
#include <hip/hip_runtime.h>
#include <cstdio>
#include <cstdint>
namespace pg8 {
#define PG8_LAS __attribute__((address_space(3)))
typedef unsigned short bf16_t;
typedef short bf16x8 __attribute__((ext_vector_type(8)));
typedef float f32x4 __attribute__((ext_vector_type(4)));
typedef float f32x2 __attribute__((ext_vector_type(2)));
typedef unsigned u32x4 __attribute__((ext_vector_type(4)));
typedef unsigned u32x2 __attribute__((ext_vector_type(2)));
constexpr int BM = 256, BK = 64, HALF = 128, HTB = HALF * BK * 2  , STAGE_BYTES = 8 * HTB, NXCD = 8, WGM = 8;

__host__ __device__ __forceinline__ int lds_byte(int r, int c) { const int st = (r >> 4) * 2 + (c >> 5), rr = r & 15, cc = c & 31, ob = rr * 64 + cc * 2; return st * 1024 + (ob ^ (((ob >> 9) & 1) << 5)); }
__host__ __device__ __forceinline__ void stage_rc(int b, int& R, int& C) { const int st = b / 1024, sb = b % 1024, swz = sb ^ (((sb >> 9) & 1) << 5); R = (st >> 1) * 16 + swz / 64; C = (st & 1) * 32 + (swz % 64) / 2; }
__host__ __device__ __forceinline__ int perm32(int rho) { const int n = rho >> 4, i = rho & 15; return 8 * (i >> 2) + 4 * n + (i & 3); }

struct Unit { int pm, pn, ks; };
struct Gemm { const bf16_t* A; const bf16_t* Bt; int M, N, K, lda, ldb, ksA, ksB; };

struct StaticOrder {
    int nM, nN, nwg, G, c, ks_shift;
    __host__ __device__ void init(int M, int N, int G_, int c_, int ks_shift_ = 31) { nM = M / BM; nN = N / BM; nwg = nM * nN; G = G_; c = c_; ks_shift = ks_shift_; }
    __host__ __device__ bool next(int i, Unit& u) const {
        const long L = (long)i * G + c; if (L >= nwg) return false;
        int wgid = (int)L; { const int q = nwg / NXCD, r = nwg % NXCD, xcd = wgid % NXCD, off = wgid / NXCD; wgid = (xcd < r ? xcd * (q + 1) : r * (q + 1) + (xcd - r) * q) + off; }
        const int nig = WGM * nN, gid = wgid / nig, fm = gid * WGM, gsz = (nM - fm) < WGM ? (nM - fm) : WGM;
        u.pm = fm + ((wgid % nig) % gsz); u.pn = (wgid % nig) / gsz; u.ks = u.pn >> ks_shift; return true;
    }
    __device__ __forceinline__ void a_ready(const Unit&) const {}
    __device__ __forceinline__ void done(const Unit&) const {}
};

struct SplitKOrder {
    int pm0, nP, nN, KS, G, c;
    __device__ __forceinline__ bool next(int i, Unit& u) const { const int L = i * G + c; if (L >= nP * nN * KS) return false; u.ks = L % KS; const int t = L / KS; u.pn = t % nN; u.pm = pm0 + t / nN; return true; }
    __device__ __forceinline__ void a_ready(const Unit&) const {}
    __device__ __forceinline__ void done(const Unit&) const {}
};

typedef __bf16 bf16x2_t __attribute__((ext_vector_type(2)));
__device__ __forceinline__ unsigned cvt_pk_bf16(float lo, float hi) { f32x2 v = {lo, hi}; bf16x2_t b = __builtin_convertvector(v, bf16x2_t); return __builtin_bit_cast(unsigned, b); }
__device__ __forceinline__ float fast_sigmoid(float x) { return __builtin_amdgcn_rcpf(1.0f + __builtin_amdgcn_exp2f(-1.4426950408889634f * x)); }

struct EpiF32 {
    static constexpr bool PERM = false, AFTER_DRAIN = false;
    float* C0; int ldc, pm0; size_t ks_stride;
    __device__ __forceinline__ void operator()(const f32x4 (&acc)[2][2][4][2], const Unit& u, int wr, int wc, int fr, int fq) const {
        float* C = C0 + (size_t)u.ks * ks_stride;
        const int row0 = (u.pm - pm0) * BM + wr * 64 + fr, col0 = u.pn * BM + wc * 32 + 4 * fq;
#pragma unroll
        for (int ai = 0; ai < 2; ++ai)
#pragma unroll
            for (int m = 0; m < 4; ++m) { float* rowp = C + (size_t)(row0 + ai * HALF + m * 16) * ldc + col0;
#pragma unroll
                for (int bj = 0; bj < 2; ++bj)
#pragma unroll
                    for (int n = 0; n < 2; ++n) *(f32x4*)(rowp + bj * HALF + n * 16) = acc[ai][bj][m][n]; }
    }
};
struct EpiBf16P {
    static constexpr bool PERM = true, AFTER_DRAIN = false;
    bf16_t* O; int ldc;
    __device__ __forceinline__ void operator()(const f32x4 (&acc)[2][2][4][2], const Unit& u, int wr, int wc, int fr, int fq) const {
        const int row0 = u.pm * BM + wr * 64 + fr, col0 = u.pn * BM + wc * 32 + 8 * fq;
#pragma unroll
        for (int ai = 0; ai < 2; ++ai)
#pragma unroll
            for (int m = 0; m < 4; ++m) { bf16_t* rowp = O + (size_t)(row0 + ai * HALF + m * 16) * ldc + col0;
#pragma unroll
                for (int bj = 0; bj < 2; ++bj) { const f32x4 v0 = acc[ai][bj][m][0], v1 = acc[ai][bj][m][1];
                    u32x4 w; w.x = cvt_pk_bf16(v0[0], v0[1]); w.y = cvt_pk_bf16(v0[2], v0[3]); w.z = cvt_pk_bf16(v1[0], v1[1]); w.w = cvt_pk_bf16(v1[2], v1[3]);
                    *(u32x4*)(rowp + bj * HALF) = w; } }
    }
};
struct EpiSwiGLU {
    static constexpr bool PERM = true, AFTER_DRAIN = false;
    bf16_t* O; int ldo;
    __device__ __forceinline__ void operator()(const f32x4 (&acc)[2][2][4][2], const Unit& u, int wr, int wc, int fr, int fq) const {
        const int row0 = u.pm * BM + wr * 64 + fr, col0 = u.pn * HALF + wc * 32 + 8 * fq;
#pragma unroll
        for (int ai = 0; ai < 2; ++ai)
#pragma unroll
            for (int m = 0; m < 4; ++m) { bf16_t* rowp = O + (size_t)(row0 + ai * HALF + m * 16) * ldo + col0;
                float h[8];
#pragma unroll
                for (int n = 0; n < 2; ++n)
#pragma unroll
                    for (int e = 0; e < 4; ++e) { const float gt = acc[ai][0][m][n][e], up = acc[ai][1][m][n][e]; h[4 * n + e] = gt * up * fast_sigmoid(gt); }
                u32x4 w; w.x = cvt_pk_bf16(h[0], h[1]); w.y = cvt_pk_bf16(h[2], h[3]); w.z = cvt_pk_bf16(h[4], h[5]); w.w = cvt_pk_bf16(h[6], h[7]);
                *(u32x4*)rowp = w; }
    }
};
struct EpiGates {
    static constexpr bool PERM = true, AFTER_DRAIN = false;
    bf16_t* G; const float* br; const float* bi; const float* k8; const bf16_t* XC;
    __device__ __forceinline__ void operator()(const f32x4 (&acc)[2][2][4][2], const Unit& u, int wr, int wc, int fr, int fq) const {
        const int row0 = u.pm * BM + wr * 64 + fr; const int hh = u.pn >> 2, d = (u.pn >> 1) & 1, half = u.pn & 1;
        const int c0 = 256 * hh + 128 * half + 32 * wc + 8 * fq;
        const f32x4 br0 = *(const f32x4*)(br + d * 1024 + c0), br1 = *(const f32x4*)(br + d * 1024 + c0 + 4), bi0 = *(const f32x4*)(bi + d * 1024 + c0), bi1 = *(const f32x4*)(bi + d * 1024 + c0 + 4);
        const f32x4 k80 = *(const f32x4*)(k8 + d * 1024 + c0), k81 = *(const f32x4*)(k8 + d * 1024 + c0 + 4);
#pragma unroll
        for (int ai = 0; ai < 2; ++ai)
#pragma unroll
            for (int m = 0; m < 4; ++m) { const size_t row = (size_t)(row0 + ai * HALF + m * 16); bf16_t* rowp = G + row * 4096 + (2 * d) * 1024 + c0; float la[8], bb[8];
                const u32x4 xw = *(const u32x4*)(XC + row * 1024 + c0);
#pragma unroll
                for (int q = 0; q < 8; ++q) {
                    const float xr = acc[ai][0][m][q >> 2][q & 3] + (q < 4 ? br0[q & 3] : br1[q & 3]), xi = acc[ai][1][m][q >> 2][q & 3] + (q < 4 ? bi0[q & 3] : bi1[q & 3]);
                    const float er = 1.0f + __builtin_amdgcn_exp2f(fminf(-1.4426950408889634f * xr, 60.f)), ei = 1.0f + __builtin_amdgcn_exp2f(fminf(-1.4426950408889634f * xi, 60.f));
                    const float rc = __builtin_amdgcn_rcpf(er * ei), sr = ei * rc, si = er * rc;
                    const unsigned xq = q < 2 ? xw.x : q < 4 ? xw.y : q < 6 ? xw.z : xw.w; const float xc = (q & 1) ? __uint_as_float(xq & 0xffff0000u) : __uint_as_float(xq << 16);
                    la[q] = (q < 4 ? k80[q & 3] : k81[q & 3]) * sr; const float a = __builtin_amdgcn_exp2f(la[q]);
                    bb[q] = __builtin_amdgcn_sqrtf(fmaxf(__builtin_fmaf(-a, a, 1.0f), 0.f)) * (si * xc); }
                u32x4 w; w.x = cvt_pk_bf16(la[0], la[1]); w.y = cvt_pk_bf16(la[2], la[3]); w.z = cvt_pk_bf16(la[4], la[5]); w.w = cvt_pk_bf16(la[6], la[7]);
                *(u32x4*)rowp = w;
                w.x = cvt_pk_bf16(bb[0], bb[1]); w.y = cvt_pk_bf16(bb[2], bb[3]); w.z = cvt_pk_bf16(bb[4], bb[5]); w.w = cvt_pk_bf16(bb[6], bb[7]);
                *(u32x4*)(rowp + 1024) = w;
                if (m & 1) asm volatile("" ::: "memory"); }
    }
};
struct EpiMixIn {
    static constexpr bool PERM = true, AFTER_DRAIN = false;
    bf16_t* P; bf16_t* U;
    __device__ __forceinline__ void operator()(const f32x4 (&acc)[2][2][4][2], const Unit& u, int wr, int wc, int fr, int fq) const {
        const int row0 = u.pm * BM + wr * 64 + fr;
        if (u.pn < 8) {
            const int col0 = u.pn * BM + wc * 32 + 8 * fq;
#pragma unroll
            for (int ai = 0; ai < 2; ++ai)
#pragma unroll
                for (int m = 0; m < 4; ++m) { bf16_t* rowp = P + (size_t)(row0 + ai * HALF + m * 16) * 2048 + col0;
#pragma unroll
                    for (int bj = 0; bj < 2; ++bj) { const f32x4 v0 = acc[ai][bj][m][0], v1 = acc[ai][bj][m][1];
                        u32x4 w; w.x = cvt_pk_bf16(v0[0], v0[1]); w.y = cvt_pk_bf16(v0[2], v0[3]); w.z = cvt_pk_bf16(v1[0], v1[1]); w.w = cvt_pk_bf16(v1[2], v1[3]);
                        *(u32x4*)(rowp + bj * HALF) = w; } }
        } else {
            const int col0 = (u.pn - 8) * HALF + wc * 32 + 8 * fq;
#pragma unroll
            for (int ai = 0; ai < 2; ++ai)
#pragma unroll
                for (int m = 0; m < 4; ++m) { bf16_t* rowp = U + (size_t)(row0 + ai * HALF + m * 16) * 1024 + col0; float h[8];
#pragma unroll
                    for (int n = 0; n < 2; ++n)
#pragma unroll
                        for (int e = 0; e < 4; ++e) h[4 * n + e] = acc[ai][0][m][n][e] * fast_sigmoid(acc[ai][1][m][n][e]);
                    u32x4 w; w.x = cvt_pk_bf16(h[0], h[1]); w.y = cvt_pk_bf16(h[2], h[3]); w.z = cvt_pk_bf16(h[4], h[5]); w.w = cvt_pk_bf16(h[6], h[7]);
                    *(u32x4*)rowp = w; }
        }
    }
};

template <class Epi, class Sched, bool ALIGN_EPI = false, bool SP2 = false>
__device__ __forceinline__ void gemm_phase(PG8_LAS unsigned char* lds, const Gemm g, const Sched& S, const Epi& E) {
    int tid_ = threadIdx.x; asm volatile("" : "+v"(tid_));
    const int tid = tid_, wid = __builtin_amdgcn_readfirstlane(tid >> 6), lane = tid & 63, wr = wid >> 2, wc = wid & 3, fr = lane & 15, fq = lane >> 4;
    const int K = g.K, nt = K / BK;
    unsigned voffA[2], voffB[2];
#pragma unroll
    for (int i = 0; i < 2; ++i) { int R, C; stage_rc(tid * 16 + i * 8192, R, C); const int Rb = Epi::PERM ? ((R & ~31) + perm32(R & 31)) : R;
        voffA[i] = (unsigned)(R * g.lda + C) * 2u; voffB[i] = (unsigned)(Rb * g.ldb + C) * 2u; }
    const size_t kstep = (size_t)(BK * 2);
    const size_t hsA = (size_t)HALF * g.lda * 2, hsB = (size_t)HALF * g.ldb * 2;
    const size_t tsA = 2 * hsA, tsB = 2 * hsB;
    const unsigned ldsw = (unsigned)wid * 1024u;
    const int aoff = lds_byte(wr * 64 + fr, fq * 8), boff = lds_byte(wc * 32 + fr, fq * 8);
#define PG8_SA(b, h) (((b) * 2 + (h)) * HTB)
#define PG8_SB(b, h) ((4 + (b) * 2 + (h)) * HTB)
#define PG8_STAGE(bufoff, gbase, voff) do { _Pragma("unroll") for (int _i = 0; _i < 2; ++_i) \
        __builtin_amdgcn_global_load_lds((const unsigned*)((const char*)(gbase) + (voff)[_i]), (PG8_LAS unsigned*)(lds + (bufoff) + ldsw + _i * 8192), 16, 0, 0); } while (0)
#define PG8_LDA(dst, b, h) do { _Pragma("unroll") for (int m = 0; m < 4; ++m) _Pragma("unroll") for (int k = 0; k < 2; ++k) dst[m][k] = *(const PG8_LAS bf16x8*)(lds + PG8_SA(b, h) + aoff + m * 2048 + k * 1024); } while (0)
#define PG8_LDB(dst, b, h) do { _Pragma("unroll") for (int n = 0; n < 2; ++n) _Pragma("unroll") for (int k = 0; k < 2; ++k) dst[n][k] = *(const PG8_LAS bf16x8*)(lds + PG8_SB(b, h) + boff + n * 2048 + k * 1024); } while (0)
#define PG8_MMA(ai, bj, At, Bt) do { __builtin_amdgcn_s_setprio(1); _Pragma("unroll") for (int m = 0; m < 4; ++m) _Pragma("unroll") for (int n = 0; n < 2; ++n) _Pragma("unroll") for (int k = 0; k < 2; ++k) \
        acc[ai][bj][m][n] = __builtin_amdgcn_mfma_f32_16x16x32_bf16(Bt[n][k], At[m][k], acc[ai][bj][m][n], 0, 0, 0); __builtin_amdgcn_s_setprio(0); } while (0)
#define PG8_WAIT_V(n) asm volatile("s_waitcnt vmcnt(" #n ")" ::: "memory")
#define PG8_WAIT_L(n) asm volatile("s_waitcnt lgkmcnt(" #n ")" ::: "memory")
#define PG8_BAR __builtin_amdgcn_s_barrier()
#define PG8_SCHED __builtin_amdgcn_sched_barrier(0)
    Unit cur, nxt; int ui = 0;
    if (!S.next(0, cur)) return;
    f32x4 acc[2][2][4][2];
#pragma unroll
    for (int a = 0; a < 2; ++a)
#pragma unroll
        for (int b = 0; b < 2; ++b)
#pragma unroll
            for (int m = 0; m < 4; ++m)
#pragma unroll
                for (int n = 0; n < 2; ++n) acc[a][b][m][n] = (f32x4){0.f, 0.f, 0.f, 0.f};
    bf16x8 At[4][2], B0[2][2], B1[2][2];
    const char* cA = (const char*)g.A + (size_t)cur.pm * tsA + (size_t)cur.ks * g.ksA; const char* cB = (const char*)g.Bt + (size_t)cur.pn * tsB + (size_t)cur.ks * g.ksB;
    S.a_ready(cur);
    if constexpr (SP2) {
        PG8_STAGE(PG8_SB(0, 0), cB, voffB); PG8_STAGE(PG8_SB(0, 1), cB + hsB, voffB); PG8_STAGE(PG8_SA(0, 0), cA, voffA); PG8_STAGE(PG8_SA(0, 1), cA + hsA, voffA);
        if (wr == 1) PG8_BAR;
        PG8_WAIT_V(2); PG8_BAR;
        PG8_STAGE(PG8_SB(1, 0), cB + kstep, voffB); PG8_STAGE(PG8_SA(1, 0), cA + kstep, voffA); PG8_STAGE(PG8_SB(1, 1), cB + hsB + kstep, voffB);
        PG8_WAIT_V(6); PG8_BAR;
    } else {
        PG8_STAGE(PG8_SB(0, 0), cB, voffB); PG8_STAGE(PG8_SA(0, 0), cA, voffA); PG8_STAGE(PG8_SB(0, 1), cB + hsB, voffB); PG8_STAGE(PG8_SA(0, 1), cA + hsA, voffA);
        if (wr == 1) PG8_BAR;
        PG8_WAIT_V(4); PG8_BAR;
        PG8_STAGE(PG8_SB(1, 0), cB + kstep, voffB); PG8_STAGE(PG8_SA(1, 0), cA + kstep, voffA); PG8_STAGE(PG8_SB(1, 1), cB + hsB + kstep, voffB);
        PG8_WAIT_V(6); PG8_BAR;
    }
    for (;;) {
        const bool has_next = S.next(ui + 1, nxt);
        const char* nA = has_next ? (const char*)g.A + (size_t)nxt.pm * tsA + (size_t)nxt.ks * g.ksA : cA; const char* nB = has_next ? (const char*)g.Bt + (size_t)nxt.pn * tsB + (size_t)nxt.ks * g.ksB : cB;
        for (int t = 0; t < nt; t += 2) {
            const bool last = (t == nt - 2);
            const char* a1 = cA + (size_t)(t + 1) * kstep;
            const char* a2 = last ? nA : cA + (size_t)(t + 2) * kstep; const char* b2 = last ? nB : cB + (size_t)(t + 2) * kstep;
            const char* a3 = a2 + kstep; const char* b3 = b2 + kstep;
            if (last && has_next) S.a_ready(nxt);
            if constexpr (SP2) {
            PG8_LDB(B0, 0, 0); PG8_LDB(B1, 0, 1); PG8_SCHED; PG8_LDA(At, 0, 0); PG8_STAGE(PG8_SA(1, 1), a1 + hsA, voffA);
            PG8_WAIT_V(8); PG8_WAIT_L(0); PG8_BAR; PG8_MMA(0, 0, At, B0); PG8_MMA(0, 1, At, B1); PG8_BAR; PG8_SCHED;
            PG8_LDA(At, 0, 1); PG8_STAGE(PG8_SB(0, 0), b2, voffB); PG8_STAGE(PG8_SB(0, 1), b2 + hsB, voffB); PG8_STAGE(PG8_SA(0, 0), a2, voffA);
            PG8_WAIT_V(8); PG8_WAIT_L(0); PG8_BAR; PG8_MMA(1, 0, At, B0); PG8_MMA(1, 1, At, B1); PG8_BAR; PG8_SCHED;
            PG8_LDB(B0, 1, 0); PG8_LDB(B1, 1, 1); PG8_SCHED; PG8_LDA(At, 1, 0); PG8_STAGE(PG8_SA(0, 1), a2 + hsA, voffA);
            PG8_WAIT_V(8); PG8_WAIT_L(0); PG8_BAR; PG8_MMA(0, 0, At, B0); PG8_MMA(0, 1, At, B1); PG8_BAR; PG8_SCHED;
            PG8_LDA(At, 1, 1); PG8_STAGE(PG8_SB(1, 0), b3, voffB); PG8_STAGE(PG8_SB(1, 1), b3 + hsB, voffB); PG8_STAGE(PG8_SA(1, 0), a3, voffA);
            PG8_WAIT_V(8); PG8_WAIT_L(0); PG8_BAR; PG8_MMA(1, 0, At, B0); PG8_MMA(1, 1, At, B1); PG8_BAR; PG8_SCHED;
            } else {
            PG8_LDB(B0, 0, 0); PG8_SCHED; PG8_LDA(At, 0, 0); PG8_STAGE(PG8_SA(1, 1), a1 + hsA, voffA);
            PG8_WAIT_L(8); PG8_BAR; PG8_WAIT_L(0); PG8_MMA(0, 0, At, B0); PG8_BAR; PG8_SCHED;
            PG8_LDB(B1, 0, 1); PG8_STAGE(PG8_SB(0, 0), b2, voffB);
            PG8_BAR; PG8_WAIT_L(0); PG8_MMA(0, 1, At, B1); PG8_BAR;
            PG8_LDA(At, 0, 1); PG8_STAGE(PG8_SA(0, 0), a2, voffA);
            PG8_BAR; PG8_WAIT_L(0); PG8_MMA(1, 0, At, B0); PG8_BAR; PG8_SCHED;
            PG8_STAGE(PG8_SB(0, 1), b2 + hsB, voffB);
            PG8_WAIT_V(6); PG8_BAR; PG8_MMA(1, 1, At, B1); PG8_BAR;
            PG8_LDB(B0, 1, 0); PG8_SCHED; PG8_LDA(At, 1, 0); PG8_STAGE(PG8_SA(0, 1), a2 + hsA, voffA);
            PG8_WAIT_L(8); PG8_BAR; PG8_WAIT_L(0); PG8_MMA(0, 0, At, B0); PG8_BAR; PG8_SCHED;
            PG8_LDB(B1, 1, 1); PG8_STAGE(PG8_SB(1, 0), b3, voffB);
            PG8_BAR; PG8_WAIT_L(0); PG8_MMA(0, 1, At, B1); PG8_BAR;
            PG8_LDA(At, 1, 1); PG8_STAGE(PG8_SA(1, 0), a3, voffA);
            PG8_BAR; PG8_WAIT_L(0); PG8_MMA(1, 0, At, B0); PG8_BAR; PG8_SCHED;
            PG8_STAGE(PG8_SB(1, 1), b3 + hsB, voffB);
            PG8_WAIT_V(6); PG8_BAR; PG8_MMA(1, 1, At, B1); PG8_BAR;
            }
        }
        if constexpr (ALIGN_EPI) { if (wr == 0) PG8_BAR; }
        if constexpr (!Epi::AFTER_DRAIN) { E(acc, cur, wr, wc, fr, fq); S.done(cur); }
        if (!has_next) break;
#pragma unroll
        for (int a = 0; a < 2; ++a)
#pragma unroll
            for (int b = 0; b < 2; ++b)
#pragma unroll
                for (int m = 0; m < 4; ++m)
#pragma unroll
                    for (int n = 0; n < 2; ++n) acc[a][b][m][n] = (f32x4){0.f, 0.f, 0.f, 0.f};
        cur = nxt; cA = nA; cB = nB; ++ui;
        if constexpr (ALIGN_EPI) { if (wr == 1) PG8_BAR; }
    }
    PG8_WAIT_V(0);
    if constexpr (!ALIGN_EPI) { if (wr == 0) PG8_BAR; }
    PG8_BAR;
    if constexpr (Epi::AFTER_DRAIN) { E.fused(acc, cur, wr, wc, fr, fq, lds, wid, lane); S.done(cur); }
#undef PG8_SA
#undef PG8_SB
#undef PG8_STAGE
#undef PG8_LDA
#undef PG8_LDB
#undef PG8_MMA
#undef PG8_WAIT_V
#undef PG8_WAIT_L
#undef PG8_BAR
#undef PG8_SCHED
}
}

constexpr int NWAVES = 8;
constexpr int D = 2048, BATCH = 2, SEQ = 8192, CTXL = 256, DEPTH = 2;
constexpr int RL = BATCH * SEQ, RC = BATCH * CTXL, R = RL + RC;
constexpr int DFF = 5632, NFF = 2 * DFF, DLRU = 1024, DCONV = 1024, DIN = 4096, NMOD = 9, NADA = NMOD * D;
constexpr int CONVK = 31, GRIDW = 64;
constexpr float LN_EPS = 1e-6f, ALPHA = 1.41421356237309515f;
constexpr int SUBL = 32, NSUB = R / SUBL;
#ifndef MK_PER_PHASE
#define MK_PER_PHASE 0
#endif
constexpr int N_PHASES = 2 + 14 * DEPTH;
constexpr int KS_FFN = 11, KS_WOUT = 8, KS_MIX = 8;
constexpr int PLD = 2 * DLRU;

enum { I_X = 0, I_C, I_CTX, I_CCTX, I_WADA, I_BADA, I_LNG, I_LNB, I_FF1IN, I_FF1OUT, I_FF2IN, I_FF2OUT, I_WIN, I_C4W, I_C4B, I_WRG, I_BRG, I_WIG, I_BIG, I_LAM, I_C31W, I_C31B, I_CLNG, I_CLNB, I_WOUT, I_BOUT, N_IN };

constexpr size_t MiB = 1u << 20;
constexpr size_t WS_CTL = 0, CTL_ZERO_BYTES = 1 * MiB;
constexpr size_t WS_MOD = 1 * MiB;
constexpr size_t WS_SA = 2 * MiB, WS_SB = 7 * MiB, WS_HIN = 12 * MiB;
constexpr size_t WS_W1T = 17 * MiB;
constexpr size_t WS_W2T = 193 * MiB;
constexpr size_t WS_WINT = 281 * MiB;
constexpr size_t WS_WOUTT = 313 * MiB;
constexpr size_t WS_WGT = 329 * MiB;
constexpr size_t WS_XS = 333 * MiB;
constexpr size_t WS_A = 465 * MiB;
constexpr size_t WS_F = 531 * MiB;
constexpr size_t WS_HID = 663 * MiB;
constexpr size_t WS_Y = 845 * MiB;
constexpr size_t WS_SLAB = 911 * MiB;
constexpr size_t WS_PSLAB = 955 * MiB;
constexpr size_t WS_END = 1019 * MiB;
static_assert(WS_W1T + (size_t)4 * NFF * D * 2 <= WS_W2T && WS_W2T + (size_t)4 * D * DFF * 2 <= WS_WINT && WS_WINT + (size_t)2 * DIN * D * 2 <= WS_WOUTT && WS_WOUTT + (size_t)2 * D * D * 2 <= WS_WGT && WS_WGT + (size_t)2 * 4096 * 256 * 2 <= WS_XS, "ws map (weights)");
static_assert(WS_XS + (size_t)R * D * 4 <= WS_A && WS_A + (size_t)R * D * 2 <= WS_F && WS_F + (size_t)R * D * 4 <= WS_HID && WS_HID + (size_t)R * DFF * 2 <= WS_Y && WS_Y + (size_t)R * D * 2 <= WS_SLAB && WS_SLAB + (size_t)11 * RC * D * 4 <= WS_PSLAB && WS_PSLAB + (size_t)8 * RC * DIN * 4 <= WS_END, "ws map (activations)");
static_assert((size_t)R * DIN * 2 <= (size_t)R * D * 4 && (size_t)R * 4096 * 2 + (size_t)R * 1024 * 2 <= (size_t)R * DFF * 2 && (size_t)NSUB * 2 * 1024 * 4 <= 5 * MiB, "ws overlays");
constexpr int CW_TMO = 0, CW_CODE = 1, CW_BAR = 4096, CW_Q = 8192;

constexpr int RING_OFF = 0, RING_BYTES = 131072;
constexpr int LDSCTL_OFF = RING_BYTES, MISC_OFF = LDSCTL_OFF + 320;
constexpr int LDS_BYTES = 147456;

#define GAS __attribute__((address_space(1)))
#define LAS __attribute__((address_space(3)))
typedef unsigned short bf16;
typedef unsigned v4u __attribute__((ext_vector_type(4)));
typedef unsigned v2u __attribute__((ext_vector_type(2)));
typedef float f32x4 __attribute__((ext_vector_type(4)));
typedef float f32x2 __attribute__((ext_vector_type(2)));
typedef GAS unsigned gu32;
typedef _Float16 f16x4 __attribute__((ext_vector_type(4)));
#define RLX_AGENT __ATOMIC_RELAXED, __HIP_MEMORY_SCOPE_AGENT
#define LDS_WAIT() asm volatile("s_waitcnt lgkmcnt(0)" ::: "memory")
#define VM_WAIT() asm volatile("s_waitcnt vmcnt(0)" ::: "memory")
__device__ __forceinline__ unsigned f2bf(float f) { unsigned u = __builtin_bit_cast(unsigned, f); return (u + 0x7fffu + ((u >> 16) & 1u)) >> 16; }
__device__ __forceinline__ unsigned pk2(float lo, float hi) { return pg8::cvt_pk_bf16(lo, hi); }
__device__ __forceinline__ float bflo(unsigned u) { return __uint_as_float(u << 16); }
__device__ __forceinline__ float bfhi(unsigned u) { return __uint_as_float(u & 0xffff0000u); }
__device__ __forceinline__ float sigm(float x) { return __builtin_amdgcn_rcpf(1.0f + __builtin_amdgcn_exp2f(-1.4426950408889634f * x)); }
template <int CTRL> __device__ __forceinline__ float dpp_mov(float v) { return __builtin_bit_cast(float, __builtin_amdgcn_update_dpp(0, __builtin_bit_cast(int, v), CTRL, 0xf, 0xf, true)); }
__device__ __forceinline__ float wave_sum(float v) {
    v += dpp_mov<0xB1>(v); v += dpp_mov<0x4E>(v); v += dpp_mov<0x141>(v); v += dpp_mov<0x140>(v);
    { auto r = __builtin_amdgcn_permlane16_swap(__float_as_uint(v), __float_as_uint(v), false, false); v = __uint_as_float(r[0]) + __uint_as_float(r[1]); }
    { auto r = __builtin_amdgcn_permlane32_swap(__float_as_uint(v), __float_as_uint(v), false, false); v = __uint_as_float(r[0]) + __uint_as_float(r[1]); }
    return v;
}

#define XB_TMO      128
#define XB_XCNT(j)  (256  + 64 * (j))
#define XB_XSUB(j)  (1280 + 64 * (j))
#define XB_XGEN(j)  (2304 + 64 * (j))
#define XB_TOP      3328
#define XB_TOPGEN   3392
#define XCD_BAR_WORDS 3456
#define XB_SPIN_CAP (1u << 18)

__device__ __forceinline__ unsigned xb_ld(unsigned* p)              { return __hip_atomic_load(p, __ATOMIC_RELAXED, __HIP_MEMORY_SCOPE_AGENT); }
__device__ __forceinline__ unsigned xb_add(unsigned* p, unsigned v) { return __hip_atomic_fetch_add(p, v, __ATOMIC_RELAXED, __HIP_MEMORY_SCOPE_AGENT); }
__device__ __forceinline__ unsigned xb_xcc_id() { return (unsigned)__builtin_amdgcn_s_getreg((3 << 11) | 20) & 0xFu; }
#define XB_SPIN(cond, bar) do { unsigned _sp = 0; while (cond) { __builtin_amdgcn_s_sleep(1); \
    if ((++_sp & 255u) == 0u) { if (xb_ld(&(bar)[XB_TMO])) break; if (_sp > XB_SPIN_CAP) { atomicAdd(&(bar)[XB_TMO], 1u); break; } } } } while (0)

struct XcdBarrier {
    unsigned* bar; unsigned x;
    volatile LAS unsigned* st;
};
__device__ __forceinline__ XcdBarrier xcd_barrier_post(unsigned* bar, volatile LAS unsigned* st) {
    XcdBarrier b; b.bar = bar; b.x = xb_xcc_id(); b.st = st;
    if (threadIdx.x == 0) (void)xb_add(&bar[XB_XCNT(b.x)], 1u);
    return b;
}
__device__ __forceinline__ void xcd_barrier_complete(unsigned* bar, unsigned x, unsigned& nloc, unsigned& nx) {
    const unsigned G = gridDim.x * gridDim.y * gridDim.z;
    unsigned sum, cnt, mine, sp = 0u;
    for (;;) {
        sum = 0u; cnt = 0u; mine = 0u;
#pragma unroll
        for (unsigned j = 0; j < 16; ++j) { const unsigned c = xb_ld(&bar[XB_XCNT(j)]); sum += c; cnt += (c > 0u) ? 1u : 0u; mine = (j == x) ? c : mine; }
        if (sum == G) break;
        __builtin_amdgcn_s_sleep(1);
        if ((++sp & 255u) == 0u) { if (xb_ld(&bar[XB_TMO])) break; if (sp > XB_SPIN_CAP) { atomicAdd(&bar[XB_TMO], 1u); break; } }
    }
    nloc = mine > 0u ? mine : 1u; nx = cnt > 0u ? cnt : 1u;
}
__device__ __forceinline__ void xcd_barrier(const XcdBarrier& b) {
    asm volatile("s_waitcnt vmcnt(0)" ::: "memory");
    __syncthreads();
    if (threadIdx.x == 0) {
        unsigned* bar = b.bar;
        __builtin_amdgcn_s_waitcnt(0);
        unsigned nloc = b.st[0], nx = b.st[1];
        if (nloc == 0u) { xcd_barrier_complete(bar, b.x, nloc, nx); b.st[0] = nloc; b.st[1] = nx; }
        const unsigned old = xb_add(&bar[XB_XSUB(b.x)], 1u);
        const unsigned gen = old / nloc;
        if (old + 1u == (gen + 1u) * nloc) {
            __builtin_amdgcn_fence(__ATOMIC_RELEASE, "agent");
            asm volatile("s_waitcnt vmcnt(0)" ::: "memory");
            const unsigned og = xb_add(&bar[XB_TOP], 1u);
            const unsigned tg = og / nx;
            if (og + 1u == (tg + 1u) * nx) xb_add(&bar[XB_TOPGEN], 1u);
            else XB_SPIN(xb_ld(&bar[XB_TOPGEN]) == tg, bar);
            __builtin_amdgcn_fence(__ATOMIC_ACQUIRE, "agent");
            xb_add(&bar[XB_XGEN(b.x)], 1u);
            asm volatile("s_waitcnt vmcnt(0)" ::: "memory");
        } else {
            XB_SPIN(xb_ld(&bar[XB_XGEN(b.x)]) == gen, bar);
            __builtin_amdgcn_fence(__ATOMIC_ACQUIRE, "agent");
            asm volatile("s_waitcnt vmcnt(0)" ::: "memory");
        }
    }
    __syncthreads();
}

struct Frame {
    LAS unsigned char* lds;
    gu32* ctl;
    int tid, lane, wave, G;
    const float* in[N_IN]; float* out;
    float* MOD; float *SA, *SB, *HIN;
    bf16 *W1T, *W2T, *WINT, *WOUTT, *WGT;
    _Float16* XS; bf16* A; bf16* Fb; bf16* P; bf16* HID; bf16* GT; bf16* XC; bf16* Y; float* SLAB; float* PSLAB; bf16* U; float* K8;
};

__device__ __forceinline__ void fresh(Frame& F) { int t = threadIdx.x; asm volatile("" : "+v"(t)); F.tid = t; F.lane = t & 63; F.wave = __builtin_amdgcn_readfirstlane(t >> 6); }
__device__ __forceinline__ void transpose_item(const float* W, int ldw, int src_col, bf16* WT, int ldk, int dst_row, int k0, LAS float* scr, int lane) {
    const int c4 = (lane & 7) * 4, kr = lane >> 3; f32x4 v[8];
#pragma unroll
    for (int i = 0; i < 8; ++i) v[i] = *(const f32x4*)(W + (size_t)(k0 + 8 * i + kr) * ldw + src_col + c4);
#pragma unroll
    for (int i = 0; i < 8; ++i) { LAS float* d = scr + (8 * i + kr) * 33 + c4; d[0] = v[i][0]; d[1] = v[i][1]; d[2] = v[i][2]; d[3] = v[i][3]; }
    LDS_WAIT(); asm volatile("" ::: "memory");
    const int c = lane & 7;
#pragma unroll
    for (int j = 0; j < 4; ++j) { const int n = (lane >> 3) + 8 * j; const LAS float* s = scr + (8 * c) * 33 + n;
        v4u o; o.x = pk2(s[0 * 33], s[1 * 33]); o.y = pk2(s[2 * 33], s[3 * 33]); o.z = pk2(s[4 * 33], s[5 * 33]); o.w = pk2(s[6 * 33], s[7 * 33]);
        *(v4u*)(WT + (size_t)(dst_row + n) * ldk + k0 + 8 * c) = o; }
    LDS_WAIT(); asm volatile("" ::: "memory");
}
constexpr int IT_FIN = (D / 64) * (NFF / 32), IT_FOUT = (DFF / 64) * (D / 32), IT_WIN = (D / 64) * (DIN / 32), IT_WOUT = (D / 64) * (D / 32), IT_G = (256 / 64) * (4096 / 32);
constexpr int CV_LAYER_ITEMS = 2 * IT_FIN + 2 * IT_FOUT + IT_WIN + IT_WOUT + IT_G;
#ifndef CV_TAIL_PCT
#define CV_TAIL_PCT 100
#endif
constexpr int CV_TAIL_ITEMS = (int)((long)CV_LAYER_ITEMS * CV_TAIL_PCT / 100);
__device__ __forceinline__ void convert_layer_items(Frame& F, int l, int it_begin, int it_end, int widx, int nw) {
    LAS float* scr = (LAS float*)(F.lds + RING_OFF + F.wave * 16384);
    for (int it = it_begin + widx; it < it_end; it += nw) {
        int r = it;
#define CV_FIN(f) { const int kb = r / (NFF / 32), nb = r % (NFF / 32), dst_row = 32 * nb, pn = dst_row >> 8, lc = dst_row & 255, src_col = lc < 128 ? 128 * pn + lc : DFF + 128 * pn + (lc - 128); \
            transpose_item(F.in[(f) ? I_FF2IN : I_FF1IN] + (size_t)l * D * NFF, NFF, src_col, F.W1T + (size_t)(l * 2 + (f)) * NFF * D, D, dst_row, 64 * kb, scr, F.lane); continue; }
#define CV_FOUT(f) { const int kb = r / (D / 32), nb = r % (D / 32); \
            transpose_item(F.in[(f) ? I_FF2OUT : I_FF1OUT] + (size_t)l * DFF * D, D, 32 * nb, F.W2T + (size_t)(l * 2 + (f)) * D * DFF, DFF, 32 * nb, 64 * kb, scr, F.lane); continue; }
        if (r < IT_FIN) CV_FIN(0)
        r -= IT_FIN;
        if (r < IT_FOUT) CV_FOUT(0)
        r -= IT_FOUT;
        if (r < IT_WIN) { const int kb = r / (DIN / 32), nb = r % (DIN / 32);
            const int dst_row = 32 * nb, tt = (dst_row - 2 * DLRU) >> 8, lc = dst_row & 255;
            const int src_col = dst_row < 2 * DLRU ? dst_row : (lc < 128 ? 2 * DLRU + 128 * tt + lc : 3 * DLRU + 128 * tt + (lc - 128));
            transpose_item(F.in[I_WIN] + (size_t)l * D * DIN, DIN, src_col, F.WINT + (size_t)l * DIN * D, D, dst_row, 64 * kb, scr, F.lane); continue; }
        r -= IT_WIN;
        if (r < IT_G) { const int kb = r / 128, nb = r % 128; const int dst_row = 32 * nb, pn = dst_row >> 8, lc = dst_row & 255, hh = pn >> 2, d = (pn >> 1) & 1, half = pn & 1;
            const float* src = F.in[lc < 128 ? I_WRG : I_WIG] + (size_t)((l * 2 + d) * 4 + hh) * 65536;
            transpose_item(src, 256, 128 * half + (lc & 127), F.WGT + (size_t)l * 4096 * 256, 256, dst_row, 64 * kb, scr, F.lane); continue; }
        r -= IT_G;
        if (r < IT_WOUT) { const int kb = r / (D / 32), nb = r % (D / 32);
            transpose_item(F.in[I_WOUT] + (size_t)l * D * D, D, 32 * nb, F.WOUTT + (size_t)l * D * D, D, 32 * nb, 64 * kb, scr, F.lane); continue; }
        r -= IT_WOUT;
        if (r < IT_FIN) CV_FIN(1)
        r -= IT_FIN;
        CV_FOUT(1)
#undef CV_FIN
#undef CV_FOUT
    }
}
__device__ __forceinline__ void convert_in_tail(Frame& F, int lconv, int it_begin, int it_end, int nunits) {
    fresh(F);
    const int first = nunits % F.G, nwg = F.G - first;
    if ((int)blockIdx.x < first) return;
    convert_layer_items(F, lconv, it_begin, it_end, ((int)blockIdx.x - first) * NWAVES + F.wave, nwg * NWAVES);
}
constexpr int CV_S2 = IT_FIN + IT_FOUT + IT_WIN + IT_G + IT_WOUT, CV_S1 = CV_S2 / 2;
__device__ __forceinline__ void prologue_a(Frame& F) {
    fresh(F);
    {
        LAS float* sv = (LAS float*)(F.lds + RING_OFF);
        LAS float* red = (LAS float*)(F.lds + RING_OFF + 32768);
#pragma unroll
        for (int i = F.tid; i < 3 * D; i += NWAVES * 64) { const int v = i >> 11, k = i & (D - 1); const float cv = v < 2 ? F.in[I_C][v * D + k] : F.in[I_CCTX][k]; sv[i] = cv * sigm(cv); }
        __syncthreads();
        const int cg = F.lane & 15, rg = F.lane >> 4;
#ifndef DUP_ADA
#define DUP_ADA 0
#endif
        for (int rep2 = 0; rep2 <= DUP_ADA; ++rep2)
        for (int it = blockIdx.x; it < DEPTH * (NADA / 64); it += F.G) {
            const int l = it / (NADA / 64), n0 = (it % (NADA / 64)) * 64;
            const float* W = F.in[I_WADA] + (size_t)l * D * NADA + n0 + 4 * cg;
            f32x4 a0 = {0.f, 0.f, 0.f, 0.f}, a1 = a0, a2 = a0;
#pragma unroll 8
            for (int kk = 0; kk < 64; ++kk) { const int k = F.wave * 256 + kk * 4 + rg; const f32x4 w = *(const f32x4*)(W + (size_t)k * NADA);
                a0 += w * sv[k]; a1 += w * sv[D + k]; a2 += w * sv[2 * D + k]; }
#pragma unroll
            for (int e = 0; e < 4; ++e) { a0[e] += __shfl_xor(a0[e], 16); a0[e] += __shfl_xor(a0[e], 32); a1[e] += __shfl_xor(a1[e], 16); a1[e] += __shfl_xor(a1[e], 32); a2[e] += __shfl_xor(a2[e], 16); a2[e] += __shfl_xor(a2[e], 32); }
            if (rg == 0) {
#pragma unroll
                for (int e = 0; e < 4; ++e) { red[(F.wave * 3 + 0) * 64 + 4 * cg + e] = a0[e]; red[(F.wave * 3 + 1) * 64 + 4 * cg + e] = a1[e]; red[(F.wave * 3 + 2) * 64 + 4 * cg + e] = a2[e]; }
            }
            __syncthreads();
            if (F.tid < 192) { const int v = F.tid >> 6, n = F.tid & 63; float s = F.in[I_BADA][(size_t)l * NADA + n0 + n];
#pragma unroll
                for (int w = 0; w < 8; ++w) s += red[(w * 3 + v) * 64 + n];
                F.MOD[((size_t)l * 3 + v) * NADA + n0 + n] = s; }
            __syncthreads();
        }
    }
    for (int i = blockIdx.x * (NWAVES * 64) + F.tid; i < DEPTH * 2 * DLRU; i += F.G * NWAVES * 64) F.K8[i] = -8.0f * 1.4426950408889634f * log1pf(expf(-F.in[I_LAM][i]));
    convert_layer_items(F, 0, 0, CV_LAYER_ITEMS, blockIdx.x * NWAVES + F.wave, F.G * NWAVES);
}
__device__ __forceinline__ void init_phase(Frame& F) {
    fresh(F);
    const int gw = blockIdx.x * NWAVES + F.wave, NGW = F.G * NWAVES;
    for (int row0 = gw; row0 < R; row0 += 2 * NGW) {
        f32x4 xv[2][8];
#pragma unroll
        for (int h = 0; h < 2; ++h) { const int row = row0 + h * NGW; if (row < R) { const float* src = row < RL ? F.in[I_X] + (size_t)row * D : F.in[I_CTX] + (size_t)(row - RL) * D;
#pragma unroll
            for (int j = 0; j < 8; ++j) xv[h][j] = *(const f32x4*)(src + 8 * F.lane + 512 * (j >> 1) + 4 * (j & 1)); } }
#pragma unroll
        for (int h = 0; h < 2; ++h) { const int row = row0 + h * NGW; if (row < R) { const float* m = F.MOD + (size_t)(row < RL ? (row >> 13) : 2) * NADA;
#pragma unroll
            for (int q = 0; q < 4; ++q) { const int col = 8 * F.lane + 512 * q;
                const f32x4 a0 = xv[h][2 * q] * (1.0f + *(const f32x4*)(m + D + col)) + *(const f32x4*)(m + col), a1 = xv[h][2 * q + 1] * (1.0f + *(const f32x4*)(m + D + col + 4)) + *(const f32x4*)(m + col + 4);
                v4u o; o.x = pk2(a0[0], a0[1]); o.y = pk2(a0[2], a0[3]); o.z = pk2(a1[0], a1[1]); o.w = pk2(a1[2], a1[3]);
                *(v4u*)(F.A + (size_t)row * D + col) = o; } } }
    }
}
#define LN_COL(lane, j) (8 * (lane) + 512 * ((j) >> 1) + 4 * ((j) & 1))
typedef _Float16 f16x8 __attribute__((ext_vector_type(8)));
__device__ __forceinline__ void ln_load(const float* xin, const _Float16* xh, const bf16* fb, const float* fs, int nks, int lane, f32x4 (&x)[8], f32x4 (&f)[8]) {
    if (xin) {
#pragma unroll
        for (int j = 0; j < 8; ++j) x[j] = *(const f32x4*)(xin + LN_COL(lane, j));
    } else {
#pragma unroll
        for (int q = 0; q < 4; ++q) { const f16x8 h = *(const f16x8*)(xh + LN_COL(lane, 2 * q));
            x[2 * q] = (f32x4){(float)h[0], (float)h[1], (float)h[2], (float)h[3]}; x[2 * q + 1] = (f32x4){(float)h[4], (float)h[5], (float)h[6], (float)h[7]}; }
    }
    if (nks == 0) {
#pragma unroll
        for (int q = 0; q < 4; ++q) { const v4u w = *(const v4u*)(fb + LN_COL(lane, 2 * q));
            f[2 * q] = (f32x4){bflo(w.x), bfhi(w.x), bflo(w.y), bfhi(w.y)}; f[2 * q + 1] = (f32x4){bflo(w.z), bfhi(w.z), bflo(w.w), bfhi(w.w)}; }
    } else {
#pragma unroll
        for (int j = 0; j < 8; ++j) f[j] = *(const f32x4*)(fs + LN_COL(lane, j));
        for (int ks = 1; ks < nks; ++ks) {
#pragma unroll
            for (int j = 0; j < 8; ++j) f[j] += *(const f32x4*)(fs + (size_t)ks * RC * D + LN_COL(lane, j)); }
    }
}
__device__ __forceinline__ void ln_finish(f32x4 (&x)[8], const f32x4 (&f)[8], const LAS float* Tv, const LAS float* Tg, int lane, float* xo, _Float16* xho, bf16* ao) {
    float sum = 0.f;
#pragma unroll
    for (int j = 0; j < 8; ++j) { const int col = LN_COL(lane, j); const f32x4 gg = *(const LAS f32x4*)(Tv + col), bb = *(const LAS f32x4*)(Tv + D + col);
        x[j] = ALPHA * x[j] + (gg * f[j] + bb); sum += (x[j][0] + x[j][1]) + (x[j][2] + x[j][3]); if (j & 1) asm volatile("" ::: "memory"); }
    const float mean = wave_sum(sum) * (1.0f / D); float s2 = 0.f;
#pragma unroll
    for (int j = 0; j < 8; ++j) { x[j] = x[j] - mean; s2 += (x[j][0] * x[j][0] + x[j][1] * x[j][1]) + (x[j][2] * x[j][2] + x[j][3] * x[j][3]); }
    const float rstd = 1.0f / sqrtf(wave_sum(s2) * (1.0f / D) + LN_EPS);
#pragma unroll
    for (int q = 0; q < 4; ++q) { const int col = LN_COL(lane, 2 * q); const f32x4 n0 = x[2 * q] * rstd, n1 = x[2 * q + 1] * rstd;
        const f32x4 y0 = n0 * *(const LAS f32x4*)(Tg + col) + *(const LAS f32x4*)(Tg + D + col), y1 = n1 * *(const LAS f32x4*)(Tg + col + 4) + *(const LAS f32x4*)(Tg + D + col + 4);
        if (xo) { *(f32x4*)(xo + col) = y0; *(f32x4*)(xo + col + 4) = y1; }
        else *(f16x8*)(xho + col) = (f16x8){(_Float16)y0[0], (_Float16)y0[1], (_Float16)y0[2], (_Float16)y0[3], (_Float16)y1[0], (_Float16)y1[1], (_Float16)y1[2], (_Float16)y1[3]};
        if (ao) { const f32x4 a0 = n0 * *(const LAS f32x4*)(Tv + 2 * D + col) + *(const LAS f32x4*)(Tv + 3 * D + col), a1 = n1 * *(const LAS f32x4*)(Tv + 2 * D + col + 4) + *(const LAS f32x4*)(Tv + 3 * D + col + 4);
            v4u o; o.x = pk2(a0[0], a0[1]); o.y = pk2(a0[2], a0[3]); o.z = pk2(a1[0], a1[1]); o.w = pk2(a1[2], a1[3]); *(v4u*)(ao + col) = o; }
        asm volatile("" ::: "memory"); }
}
__device__ __forceinline__ void ln_phase(Frame& F, int l, int s, bool dummy = false) {
    fresh(F);
    const bool last = (l == DEPTH - 1 && s == 2), first = (l == 0 && s == 0);
    const float gsc = (s == 1) ? 1.0f : 0.5f;
    const float* bias = (s == 1) ? F.in[I_BOUT] + (size_t)l * D : nullptr;
    const float* lg = F.in[I_LNG] + (size_t)(l * 3 + s) * D; const float* lb = F.in[I_LNB] + (size_t)(l * 3 + s) * D;
    const float* modl = F.MOD + (size_t)l * 3 * NADA;
    const float* modn = (s == 2) ? F.MOD + (size_t)(last ? l : l + 1) * 3 * NADA : modl;
    const int shi = (s == 2) ? 0 : 3 * s + 3;
    const int nrows = last ? RL : R;
    const int nks = (s == 1) ? KS_WOUT : KS_FFN;
    LAS float* T = (LAS float*)(F.lds + RING_OFF);
#pragma unroll
    for (int i = F.tid; i < 3 * D; i += NWAVES * 64) { const int v = i >> 11, col = i & (D - 1);
        const float gg = gsc * modl[(size_t)v * NADA + (3 * s + 2) * D + col], lgv = lg[col], lbv = lb[col];
        const float sh = modn[(size_t)v * NADA + shi * D + col], sc = modn[(size_t)v * NADA + (shi + 1) * D + col];
        T[(v * 4 + 0) * D + col] = gg; T[(v * 4 + 1) * D + col] = bias ? gg * bias[col] : 0.f; T[(v * 4 + 2) * D + col] = lgv * (1.0f + sc); T[(v * 4 + 3) * D + col] = lbv * (1.0f + sc) + sh;
        if (v == 0) { T[12 * D + col] = lgv; T[13 * D + col] = lbv; } }
    __syncthreads();
    const LAS float* Tg = T + 12 * D;
    const int l_begin = (int)((long)RL * blockIdx.x / F.G), l_end = (int)((long)RL * (blockIdx.x + 1) / F.G);
    const int c_begin = (int)((long)RC * blockIdx.x / F.G), nc = (l == DEPTH - 1 && s >= 1) ? 0 : (int)((long)RC * (blockIdx.x + 1) / F.G) - c_begin,     ntot = nc + (l_end - l_begin);
    LAS unsigned* ctr = (LAS unsigned*)(F.lds + MISC_OFF) + 16;
#define LN_GRAB(k_) do { unsigned g_ = 0u; if (F.lane == 0) g_ = __hip_atomic_fetch_add(ctr, 1u, __ATOMIC_RELAXED, __HIP_MEMORY_SCOPE_WORKGROUP); k_ = __builtin_amdgcn_readfirstlane((int)g_); } while (0)
#define LN_ROW(k_) ((k_) < nc ? RL + c_begin + (k_) : l_begin + ((k_) - nc))
#define LN_SRC(row, xin, fin, nk) const float* xin = first ? ((row) < RL ? F.in[I_X] + (size_t)(row) * D : F.in[I_CTX] + (size_t)((row) - RL) * D) : nullptr; const _Float16* xh = F.XS + (size_t)(row) * D; \
        const bf16* fb = F.Fb + (size_t)((row) < RL ? (row) : 0) * D; const float* fin = F.SLAB + (size_t)((row) < RL ? 0 : (row) - RL) * D; const int nk = (row) < RL ? 0 : nks;
#define LN_DST(row, Tv, xo, ao) const LAS float* Tv = T + ((row) < RL ? ((row) >> 13) : 2) * 4 * D; float* xo = last ? (dummy ? (float*)F.HID : F.out) + (size_t)(row) * D : nullptr; _Float16* xho = (dummy ? (_Float16*)F.HID : F.XS) + (size_t)(row) * D; bf16* ao = dummy ? F.Y + (size_t)(row) * D : last ? nullptr : F.A + (size_t)(row) * D;
    {
        f32x4 xa[8], fa[8], xb[8], fb_[8];
        int ka, kb; LN_GRAB(ka);
        if (ka < ntot) { const int rA = LN_ROW(ka); LN_SRC(rA, xin, fin, nk) ln_load(xin, xh, fb, fin, nk, F.lane, xa, fa); }
        while (ka < ntot) {
            LN_GRAB(kb);
            if (kb < ntot) { const int rB = LN_ROW(kb); LN_SRC(rB, xin, fin, nk) ln_load(xin, xh, fb, fin, nk, F.lane, xb, fb_); }
            asm volatile("" ::: "memory");
            { const int rA = LN_ROW(ka); LN_DST(rA, Tv, xo, ao) ln_finish(xa, fa, Tv, Tg, F.lane, xo, xho, ao); }
            asm volatile("" ::: "memory");
            if (kb >= ntot) break;
            LN_GRAB(ka);
            if (ka < ntot) { const int rA = LN_ROW(ka); LN_SRC(rA, xin, fin, nk) ln_load(xin, xh, fb, fin, nk, F.lane, xa, fa); }
            asm volatile("" ::: "memory");
            { const int rB = LN_ROW(kb); LN_DST(rB, Tv, xo, ao) ln_finish(xb, fb_, Tv, Tg, F.lane, xo, xho, ao); }
            asm volatile("" ::: "memory");
        }
    }
#undef LN_GRAB
#undef LN_ROW
#undef LN_SRC
#undef LN_DST
    __syncthreads();
    if (F.tid == 0) *ctr = 0u;
}
constexpr int CT = 16;
__device__ __forceinline__ void conv4_phase(Frame& F, int l) {
    fresh(F);
    {
        const float* w4 = F.in[I_C4W] + (size_t)l * 4 * DLRU; const float* b4 = F.in[I_C4B] + (size_t)l * DLRU;
        for (int idx = blockIdx.x * (NWAVES * 64) + F.tid; idx < R * (DLRU / 8); idx += F.G * NWAVES * 64) {
            const int row = idx >> 7, c8 = (idx & 127) * 8;
            int s0, s1; if (row < RL) { s0 = row & ~(SEQ - 1); s1 = s0 + SEQ; } else { s0 = RL + ((row - RL) & ~(CTXL - 1)); s1 = s0 + CTXL; }
            f32x4 a0 = *(const f32x4*)(b4 + c8), a1 = *(const f32x4*)(b4 + c8 + 4);
#pragma unroll
            for (int k = 0; k < 4; ++k) { const int rr = row + k - 2;
                if (rr >= s0 && rr < s1) { const f32x4 w0 = *(const f32x4*)(w4 + k * DLRU + c8), w1 = *(const f32x4*)(w4 + k * DLRU + c8 + 4); f32x4 x0, x1;
                    if (row < RL) { const v4u xv = *(const v4u*)(F.P + (size_t)rr * PLD + c8); x0 = (f32x4){bflo(xv.x), bfhi(xv.x), bflo(xv.y), bfhi(xv.y)}; x1 = (f32x4){bflo(xv.z), bfhi(xv.z), bflo(xv.w), bfhi(xv.w)}; }
                    else { const float* sp = F.PSLAB + (size_t)(rr - RL) * DIN + c8; x0 = *(const f32x4*)sp; x1 = *(const f32x4*)(sp + 4);
#pragma unroll
                        for (int ks = 1; ks < KS_MIX; ++ks) { x0 += *(const f32x4*)(sp + (size_t)ks * RC * DIN); x1 += *(const f32x4*)(sp + (size_t)ks * RC * DIN + 4); } }
                    a0 += w0 * x0; a1 += w1 * x1; } }
            v4u o; o.x = pk2(a0[0], a0[1]); o.y = pk2(a0[2], a0[3]); o.z = pk2(a1[0], a1[1]); o.w = pk2(a1[2], a1[3]);
            *(v4u*)(F.XC + (size_t)row * DLRU + c8) = o;
        }
    }
    if (l != DEPTH - 1) {
        for (int idx = blockIdx.x * (NWAVES * 64) + F.tid; idx < RC * 256; idx += F.G * NWAVES * 64) {
            const int rc = idx >> 8, j8 = (idx & 127) * 8; const bool glu = (idx & 128) != 0;
            const int cv_col = glu ? 2 * DLRU + 256 * (j8 >> 7) + (j8 & 127) : DLRU + j8;
            const float* sp = F.PSLAB + (size_t)rc * DIN + cv_col; f32x4 x0 = *(const f32x4*)sp, x1 = *(const f32x4*)(sp + 4), g0 = {0.f, 0.f, 0.f, 0.f}, g1 = g0;
            if (glu) { g0 = *(const f32x4*)(sp + 128); g1 = *(const f32x4*)(sp + 132); }
#pragma unroll
            for (int ks = 1; ks < KS_MIX; ++ks) { const float* sq = sp + (size_t)ks * RC * DIN; x0 += *(const f32x4*)sq; x1 += *(const f32x4*)(sq + 4); if (glu) { g0 += *(const f32x4*)(sq + 128); g1 += *(const f32x4*)(sq + 132); } }
            if (glu) {
#pragma unroll
                for (int e = 0; e < 4; ++e) { x0[e] *= sigm(g0[e]); x1[e] *= sigm(g1[e]); } }
            v4u o; o.x = pk2(x0[0], x0[1]); o.y = pk2(x0[2], x0[3]); o.z = pk2(x1[0], x1[1]); o.w = pk2(x1[2], x1[3]);
            if (glu) *(v4u*)(F.U + (size_t)(RL + rc) * DCONV + j8) = o; else *(v4u*)(F.P + (size_t)(RL + rc) * PLD + DLRU + j8) = o;
        }
    }
}
__device__ __forceinline__ void conv31_phase(Frame& F, int l, int max_items) {
    fresh(F);
    {
        const float* w31 = F.in[I_C31W] + (size_t)l * CONVK * DCONV; const float* b31 = F.in[I_C31B] + (size_t)l * DCONV;
        const float* cg_ = F.in[I_CLNG] + (size_t)l * DCONV; const float* cb_ = F.in[I_CLNB] + (size_t)l * DCONV;
        LAS f32x2* red = (LAS f32x2*)(F.lds + RING_OFF);
        LAS f32x2* stat = (LAS f32x2*)(F.lds + RING_OFF + 4096);
        const int cp = F.tid;
        f32x2 w[CONVK];
#pragma unroll
        for (int k = 0; k < CONVK; ++k) w[k] = *(const f32x2*)(w31 + k * DCONV + 2 * cp);
        const f32x2 bb = *(const f32x2*)(b31 + 2 * cp), lng = *(const f32x2*)(cg_ + 2 * cp), lnb = *(const f32x2*)(cb_ + 2 * cp);
        const int nitems = ((l == DEPTH - 1) ? RL : R) / CT;
        LAS int* itl = (LAS int*)(F.lds + MISC_OFF) + 20;
        for (int taken = 0; taken < max_items; ++taken) {
            if (F.tid == 0) *itl = (int)__hip_atomic_fetch_add(F.ctl + CW_Q + 64 * l, 1u, __ATOMIC_RELAXED, __HIP_MEMORY_SCOPE_AGENT);
            __syncthreads();
            const int it = *itl;
            if (it >= nitems) break;
            const int row0 = it * CT;
            int g0, g1; if (row0 < RL) { g0 = row0 & ~(GRIDW - 1); g1 = g0 + GRIDW; } else { g0 = RL + ((row0 - RL) & ~(CTXL - 1)); g1 = g0 + CTXL; }
            constexpr int CCH = 8, NTK = CT + CONVK - 1, NCH = (NTK + CCH - 1) / CCH;
            unsigned cva[CCH], cvb[CCH];
#define CV_LOAD(cv_, c_) do { _Pragma("unroll") for (int q = 0; q < CCH; ++q) { const int ti = (c_) * CCH + q; if (ti < NTK) { const int tok = row0 - (CONVK / 2) + ti; const int tc = (tok >= g0 && tok < g1) ? tok : row0; \
                cv_[q] = *(const unsigned*)(F.U + (size_t)tc * DCONV + 2 * cp); } } } while (0)
#define CV_USE(cv_, c_) do { _Pragma("unroll") for (int q = 0; q < CCH; ++q) { const int ti = (c_) * CCH + q; if (ti < NTK) { const int tok = row0 - (CONVK / 2) + ti; const bool ok = (tok >= g0 && tok < g1); \
                f32x2 u; u.x = ok ? bflo(cv_[q]) : 0.f; u.y = ok ? bfhi(cv_[q]) : 0.f; \
                _Pragma("unroll") for (int k = 0; k < CONVK; ++k) { const int to = ti - k; if (to >= 0 && to < CT) acc[to] += w[k] * u; } } } } while (0)
            f32x2 acc[CT];
#pragma unroll
            for (int j = 0; j < CT; ++j) acc[j] = bb;
            CV_LOAD(cva, 0);
#pragma unroll
            for (int c = 0; c < NCH; c += 2) {
                if (c + 1 < NCH) CV_LOAD(cvb, c + 1);
                CV_USE(cva, c);
                if (c + 2 < NCH) CV_LOAD(cva, c + 2);
                if (c + 1 < NCH) CV_USE(cvb, c + 1);
            }
#undef CV_LOAD
#undef CV_USE
#pragma unroll
            for (int j = 0; j < CT; ++j) { const float s1 = wave_sum(acc[j].x + acc[j].y), s2 = wave_sum(acc[j].x * acc[j].x + acc[j].y * acc[j].y);
                if (F.lane == 0) red[F.wave * CT + j] = (f32x2){s1, s2}; }
            __syncthreads();
            if (F.tid < CT) { float s1 = 0.f, s2 = 0.f;
#pragma unroll
                for (int wv = 0; wv < NWAVES; ++wv) { const f32x2 r = red[wv * CT + F.tid]; s1 += r.x; s2 += r.y; }
                const float mean = s1 * (1.0f / DCONV), var = fmaxf(s2 * (1.0f / DCONV) - mean * mean, 0.f);
                stat[F.tid] = (f32x2){mean, 1.0f / sqrtf(var + LN_EPS)}; }
            __syncthreads();
#pragma unroll
            for (int j = 0; j < CT; ++j) { const f32x2 st = stat[j];
                const float y0 = (acc[j].x - st.x) * st.y * lng.x + lnb.x, y1 = (acc[j].y - st.x) * st.y * lng.y + lnb.y;
                *(unsigned*)(F.Y + (size_t)(row0 + j) * D + DLRU + 2 * cp) = pk2(y0 * sigm(y0), y1 * sigm(y1)); }
            __syncthreads();
        }
    }
}
__device__ __forceinline__ void scan1_phase(Frame& F, int l) {
    fresh(F);
    const int cp = F.tid;
    for (int it = blockIdx.x; it < NSUB * 2; it += F.G) {
        const int sc = it >> 1, d = it & 1, r0 = sc * SUBL;
        unsigned aw[SUBL], bw[SUBL];
#pragma unroll
        for (int j = 0; j < SUBL; ++j) { const int row = d ? r0 + SUBL - 1 - j : r0 + j;
            aw[j] = *(const unsigned*)(F.GT + (size_t)row * 4096 + (2 * d) * 1024 + 2 * cp); bw[j] = *(const unsigned*)(F.GT + (size_t)row * 4096 + (2 * d + 1) * 1024 + 2 * cp); }
        float A0 = 1.f, A1 = 1.f, B0 = 0.f, B1 = 0.f;
#pragma unroll
        for (int j = 0; j < SUBL; ++j) {
            const float a0 = __builtin_amdgcn_exp2f(bflo(aw[j])), a1 = __builtin_amdgcn_exp2f(bfhi(aw[j]));
            A0 *= a0; B0 = a0 * B0 + bflo(bw[j]); A1 *= a1; B1 = a1 * B1 + bfhi(bw[j]); }
        *(f32x2*)(F.SA + (size_t)(sc * 2 + d) * DLRU + 2 * cp) = (f32x2){A0, A1};
        *(f32x2*)(F.SB + (size_t)(sc * 2 + d) * DLRU + 2 * cp) = (f32x2){B0, B1};
    }
}
__device__ __forceinline__ void scan2_phase(Frame& F) {
    fresh(F);
    if (blockIdx.x < 64 && F.tid < 64) {
        const int gt = blockIdx.x * 64 + F.tid, c = gt & 1023, d = (gt >> 10) & 1, b = gt >> 11;
        const float* __restrict__ SA = F.SA; const float* __restrict__ SB = F.SB; float* __restrict__ HIN = F.HIN;
        float carry = 0.f;
        constexpr int NCS = CTXL / SUBL, NLS = SEQ / SUBL;
#pragma unroll
        for (int q = 0; q < NCS; ++q) { const int sc = RL / SUBL + NCS * b + (d ? NCS - 1 - q : q); const size_t ix = (size_t)(sc * 2 + d) * DLRU + c; HIN[ix] = carry; carry = SA[ix] * carry + SB[ix]; }
        for (int q0 = 0; q0 < NLS; q0 += 32) { float sa[32], sb[32];
#pragma unroll
            for (int q = 0; q < 32; ++q) { const int sc = NLS * b + (d ? NLS - 1 - (q0 + q) : q0 + q); const size_t ix = (size_t)(sc * 2 + d) * DLRU + c; sa[q] = SA[ix]; sb[q] = SB[ix]; }
#pragma unroll
            for (int q = 0; q < 32; ++q) { const int sc = NLS * b + (d ? NLS - 1 - (q0 + q) : q0 + q); const size_t ix = (size_t)(sc * 2 + d) * DLRU + c; HIN[ix] = carry; carry = sa[q] * carry + sb[q]; } }
    }
}
__device__ __forceinline__ float gelu_tanh(float x) { return x * sigm(1.5957691216057308f * (x + 0.044715f * x * x * x)); }
__device__ __forceinline__ void scan3_phase(Frame& F, int l) {
    fresh(F);
    const int cp = F.tid;
    for (int sc = blockIdx.x; sc < ((l == DEPTH - 1) ? RL / SUBL : NSUB); sc += F.G) {
        const int r0 = sc * SUBL;
        unsigned af[SUBL], bf_[SUBL], ab[SUBL], bb_[SUBL], gw_[SUBL];
#pragma unroll
        for (int j = 0; j < SUBL; ++j) { const bf16* g = F.GT + (size_t)(r0 + j) * 4096 + 2 * cp;
            af[j] = *(const unsigned*)g; bf_[j] = *(const unsigned*)(g + 1024); ab[j] = *(const unsigned*)(g + 2048); bb_[j] = *(const unsigned*)(g + 3072);
            gw_[j] = *(const unsigned*)(F.P + (size_t)(r0 + j) * PLD + DLRU + 2 * cp); }
        f32x2 h = *(const f32x2*)(F.HIN + (size_t)(sc * 2 + 0) * DLRU + 2 * cp);
        LAS f32x2* hfl = (LAS f32x2*)(F.lds + RING_OFF) + cp;
#pragma unroll
        for (int j = 0; j < SUBL; ++j) {
            h.x = __builtin_amdgcn_exp2f(bflo(af[j])) * h.x + bflo(bf_[j]); h.y = __builtin_amdgcn_exp2f(bfhi(af[j])) * h.y + bfhi(bf_[j]); hfl[j * (NWAVES * 64)] = h; }
        h = *(const f32x2*)(F.HIN + (size_t)(sc * 2 + 1) * DLRU + 2 * cp);
#pragma unroll
        for (int j = SUBL - 1; j >= 0; --j) { const int row = r0 + j;
            h.x = __builtin_amdgcn_exp2f(bflo(ab[j])) * h.x + bflo(bb_[j]); h.y = __builtin_amdgcn_exp2f(bfhi(ab[j])) * h.y + bfhi(bb_[j]);
            const f32x2 hf = hfl[j * (NWAVES * 64)];
            *(unsigned*)(F.Y + (size_t)row * D + 2 * cp) = pk2((hf.x + h.x) * gelu_tanh(bflo(gw_[j])), (hf.y + h.y) * gelu_tanh(bfhi(gw_[j]))); }
    }
}

struct Args { const float* in[N_IN]; float* out; unsigned char* ws; int ph_lo, ph_hi; };
static_assert(sizeof(Args) == N_IN * 8 + 8 + 8 + 8, "Args has no padding");
__global__ void __launch_bounds__(NWAVES * 64, 2) mk_fwd(Args args) {
    extern __shared__ __attribute__((aligned(16))) unsigned char lds[];
    Frame F;
    F.lds = (LAS unsigned char*)lds;
    F.tid = threadIdx.x; F.lane = F.tid & 63; F.wave = __builtin_amdgcn_readfirstlane(F.tid >> 6); F.G = gridDim.x;
#pragma unroll
    for (int i = 0; i < N_IN; ++i) F.in[i] = args.in[i];
    F.out = args.out;
    unsigned char* ws = args.ws;
    gu32* ctl = (gu32*)(ws + WS_CTL); F.ctl = ctl;
    F.MOD = (float*)(ws + WS_MOD); F.SA = (float*)(ws + WS_SA); F.SB = (float*)(ws + WS_SB); F.HIN = (float*)(ws + WS_HIN);
    F.W1T = (bf16*)(ws + WS_W1T); F.W2T = (bf16*)(ws + WS_W2T); F.WINT = (bf16*)(ws + WS_WINT); F.WOUTT = (bf16*)(ws + WS_WOUTT); F.WGT = (bf16*)(ws + WS_WGT);
    F.XS = (_Float16*)(ws + WS_XS); F.A = (bf16*)(ws + WS_A); F.Fb = (bf16*)(ws + WS_F); F.P = (bf16*)(ws + WS_F); F.HID = (bf16*)(ws + WS_HID);
    F.GT = (bf16*)(ws + WS_HID); F.XC = (bf16*)(ws + WS_HID + 132 * MiB); F.Y = (bf16*)(ws + WS_Y); F.SLAB = (float*)(ws + WS_SLAB); F.PSLAB = (float*)(ws + WS_PSLAB); F.U = (bf16*)(ws + WS_F + 66 * MiB); F.K8 = (float*)(ws + WS_MOD + 768 * 1024);
    for (int u = F.tid; u < (LDS_BYTES - LDSCTL_OFF) / 4; u += NWAVES * 64) ((LAS unsigned*)(F.lds + LDSCTL_OFF))[u] = 0u;
    __syncthreads();
    const int lo = args.ph_lo, hi = args.ph_hi;
    XcdBarrier bar; bar.bar = (unsigned*)(ctl + CW_BAR); bar.x = 0; bar.st = nullptr;
    if (hi - lo > 1) bar = xcd_barrier_post((unsigned*)(ctl + CW_BAR), (volatile LAS unsigned*)(F.lds + MISC_OFF) + 8);
#define PH(k) (lo <= (k) && (k) < hi)
#ifndef DUP_MASK
#define DUP_MASK 0
#endif
#define NREP(j) (1 + ((DUP_MASK >> (j)) & 1))
#ifndef DUP_BAR
#define DUP_BAR 0
#endif
#define SEAM(k) do { if ((k) + 1 < hi) { xcd_barrier(bar); if (DUP_BAR) xcd_barrier(bar); } } while (0)

    if (PH(0)) for (int rep_ = 0; rep_ < NREP(14); ++rep_) { prologue_a(F); SEAM(0); }
    if (PH(1)) { init_phase(F); SEAM(1); }
#pragma unroll 1
    for (int l = 0; l < DEPTH; ++l) {
        const int pb = 2 + 14 * l;
        if (PH(pb + 0)) for (int rep_ = 0; rep_ < NREP(0); ++rep_) {
            pg8::Gemm g{F.A, F.W1T + (size_t)(l * 2 + 0) * NFF * D, R, NFF, D, D, D, 0, 0}; pg8::StaticOrder S; S.init(R, NFF, F.G, (int)blockIdx.x);
            pg8::EpiSwiGLU E{F.HID, DFF};
            pg8::gemm_phase<pg8::EpiSwiGLU, pg8::StaticOrder, true, true>(F.lds + RING_OFF, g, S, E);
            if (rep_ == 0) { if (l + 1 < DEPTH) convert_in_tail(F, l + 1, 0, CV_S1, (R / 256) * (NFF / 256)); if (l > 0) convert_in_tail(F, l, CV_S2, CV_LAYER_ITEMS, (R / 256) * (NFF / 256)); }
            SEAM(pb + 0);
        }
        if (PH(pb + 1)) for (int rep_ = 0; rep_ < NREP(1); ++rep_) {
            { pg8::Gemm g{F.HID, F.W2T + (size_t)(l * 2 + 0) * D * DFF, RL, D, DFF, DFF, DFF, 0, 0}; pg8::StaticOrder S; S.init(RL, D, F.G, (int)blockIdx.x);
              pg8::EpiBf16P E{F.Fb, D};
              pg8::gemm_phase<pg8::EpiBf16P, pg8::StaticOrder, true, true>(F.lds + RING_OFF, g, S, E); }
            { int kc = DFF / KS_FFN; asm volatile("" : "+s"(kc));
              pg8::Gemm g{F.HID, F.W2T + (size_t)(l * 2 + 0) * D * DFF, R, D, kc, DFF, DFF, 2 * (DFF / KS_FFN), 2 * (DFF / KS_FFN)}; pg8::SplitKOrder S{RL / 256, RC / 256, D / 256, KS_FFN, F.G, (int)blockIdx.x};
              pg8::EpiF32 E{F.SLAB, D, RL / 256, (size_t)RC * D};
              pg8::gemm_phase<pg8::EpiF32, pg8::SplitKOrder, true, true>(F.lds + RING_OFF, g, S, E); }
            SEAM(pb + 1);
        }
        if (PH(pb + 2)) { if (NREP(2) > 1) { ln_phase(F, l, 0, true); xcd_barrier(bar); } ln_phase(F, l, 0); SEAM(pb + 2); }
        if (PH(pb + 3)) for (int rep_ = 0; rep_ < NREP(3); ++rep_) {
            { pg8::Gemm g{F.A, F.WINT + (size_t)l * DIN * D, RL, DIN, D, D, D, 0, 0}; pg8::StaticOrder S; S.init(RL, DIN, F.G, (int)blockIdx.x);
              pg8::EpiMixIn E{F.P, F.U};
              pg8::gemm_phase<pg8::EpiMixIn, pg8::StaticOrder, true, true>(F.lds + RING_OFF, g, S, E); }
            { int kc = D / KS_MIX; asm volatile("" : "+s"(kc));
              pg8::Gemm g{F.A, F.WINT + (size_t)l * DIN * D, R, DIN, kc, D, D, 2 * (D / KS_MIX), 2 * (D / KS_MIX)}; pg8::SplitKOrder S{RL / 256, RC / 256, (l == DEPTH - 1) ? DLRU / 256 : DIN / 256, KS_MIX, F.G, (int)blockIdx.x};
              pg8::EpiF32 E{F.PSLAB, DIN, RL / 256, (size_t)RC * DIN};
              pg8::gemm_phase<pg8::EpiF32, pg8::SplitKOrder, true, true>(F.lds + RING_OFF, g, S, E); }
            SEAM(pb + 3);
        }
        if (PH(pb + 4)) for (int rep_ = 0; rep_ < NREP(4); ++rep_) { conv4_phase(F, l); SEAM(pb + 4); }
        if (PH(pb + 5)) for (int rep_ = 0; rep_ < NREP(5); ++rep_) {
            int kg = 256; asm volatile("" : "+s"(kg));
            pg8::Gemm g{F.XC, F.WGT + (size_t)l * 4096 * 256, R, 4096, kg, DLRU, 256, 512, 0}; pg8::StaticOrder S; S.init(R, 4096, F.G, (int)blockIdx.x, 2);
            pg8::EpiGates E{F.GT, F.in[I_BRG] + (size_t)l * 2 * DLRU, F.in[I_BIG] + (size_t)l * 2 * DLRU, F.K8 + (size_t)l * 2 * DLRU, F.XC};
            pg8::gemm_phase<pg8::EpiGates, pg8::StaticOrder, true, true>(F.lds + RING_OFF, g, S, E);
            if (rep_ == 0 && (int)blockIdx.x >= ((R / 256) * 16) % F.G) conv31_phase(F, l, 2);
            SEAM(pb + 5);
        }
        if (PH(pb + 6)) for (int rep_ = 0; rep_ < NREP(6); ++rep_) { scan1_phase(F, l); SEAM(pb + 6); }
        if (PH(pb + 7)) for (int rep_ = 0; rep_ < NREP(7); ++rep_) { scan2_phase(F); conv31_phase(F, l, 1 << 30); SEAM(pb + 7); }
        if (PH(pb + 8)) for (int rep_ = 0; rep_ < NREP(8); ++rep_) { scan3_phase(F, l); SEAM(pb + 8); }
        if (PH(pb + 9)) for (int rep_ = 0; rep_ < NREP(9); ++rep_) {
            { pg8::Gemm g{F.Y, F.WOUTT + (size_t)l * D * D, RL, D, D, D, D, 0, 0}; pg8::StaticOrder S; S.init(RL, D, F.G, (int)blockIdx.x);
              pg8::EpiBf16P E{F.Fb, D};
              pg8::gemm_phase<pg8::EpiBf16P, pg8::StaticOrder, true, true>(F.lds + RING_OFF, g, S, E); }
            if (l != DEPTH - 1) { int kc = D / KS_WOUT; asm volatile("" : "+s"(kc));
              pg8::Gemm g{F.Y, F.WOUTT + (size_t)l * D * D, R, D, kc, D, D, 2 * (D / KS_WOUT), 2 * (D / KS_WOUT)}; pg8::SplitKOrder S{RL / 256, RC / 256, D / 256, KS_WOUT, F.G, (int)blockIdx.x};
              pg8::EpiF32 E{F.SLAB, D, RL / 256, (size_t)RC * D};
              pg8::gemm_phase<pg8::EpiF32, pg8::SplitKOrder, true, true>(F.lds + RING_OFF, g, S, E); }
            SEAM(pb + 9);
        }
        if (PH(pb + 10)) { if (NREP(10) > 1) { ln_phase(F, l, 1, true); xcd_barrier(bar); } ln_phase(F, l, 1); SEAM(pb + 10); }
        if (PH(pb + 11)) for (int rep_ = 0; rep_ < NREP(11); ++rep_) {
            const int mrows = (l == DEPTH - 1) ? RL : R;
            pg8::Gemm g{F.A, F.W1T + (size_t)(l * 2 + 1) * NFF * D, mrows, NFF, D, D, D, 0, 0}; pg8::StaticOrder S; S.init(mrows, NFF, F.G, (int)blockIdx.x);
            pg8::EpiSwiGLU E{F.HID, DFF};
            pg8::gemm_phase<pg8::EpiSwiGLU, pg8::StaticOrder, true, true>(F.lds + RING_OFF, g, S, E);
            if (l + 1 < DEPTH && rep_ == 0) convert_in_tail(F, l + 1, CV_S1, CV_S2, (mrows / 256) * (NFF / 256));
            SEAM(pb + 11);
        }
        if (PH(pb + 12)) for (int rep_ = 0; rep_ < NREP(12); ++rep_) {
            { pg8::Gemm g{F.HID, F.W2T + (size_t)(l * 2 + 1) * D * DFF, RL, D, DFF, DFF, DFF, 0, 0}; pg8::StaticOrder S; S.init(RL, D, F.G, (int)blockIdx.x);
              pg8::EpiBf16P E{F.Fb, D};
              pg8::gemm_phase<pg8::EpiBf16P, pg8::StaticOrder, true, true>(F.lds + RING_OFF, g, S, E); }
            if (l != DEPTH - 1) { int kc = DFF / KS_FFN; asm volatile("" : "+s"(kc));
              pg8::Gemm g{F.HID, F.W2T + (size_t)(l * 2 + 1) * D * DFF, R, D, kc, DFF, DFF, 2 * (DFF / KS_FFN), 2 * (DFF / KS_FFN)}; pg8::SplitKOrder S{RL / 256, RC / 256, D / 256, KS_FFN, F.G, (int)blockIdx.x};
              pg8::EpiF32 E{F.SLAB, D, RL / 256, (size_t)RC * D};
              pg8::gemm_phase<pg8::EpiF32, pg8::SplitKOrder, true, true>(F.lds + RING_OFF, g, S, E); }
            SEAM(pb + 12);
        }
        if (PH(pb + 13)) { if (NREP(13) > 1) { ln_phase(F, l, 2, true); xcd_barrier(bar); } ln_phase(F, l, 2); SEAM(pb + 13); }
    }
#if defined(DBG_DUMP)
    if (PH(N_PHASES)) {
        for (size_t i = (size_t)blockIdx.x * (NWAVES * 64) + threadIdx.x; i < (size_t)RL * D; i += (size_t)F.G * NWAVES * 64) {
            float v;
            if (DBG_DUMP == 0) v = (float)F.XS[i]; else if (DBG_DUMP == 1) v = bflo(F.Fb[i]); else if (DBG_DUMP == 2) v = bflo(F.A[i]); else if (DBG_DUMP == 3) v = bflo(F.Y[i]);
            else if (DBG_DUMP == 4) v = bflo(F.HID[i]); else if (DBG_DUMP == 5) v = bflo(F.P[i]); else if (DBG_DUMP == 6) v = bflo(F.GT[i]); else if (DBG_DUMP == 7) v = bflo(F.XC[i % ((size_t)R * DLRU)]);
            else if (DBG_DUMP == 8) v = F.MOD[i % ((size_t)DEPTH * 3 * NADA)]; else v = F.SA[i % ((size_t)3 * 5 * 262144)];
            F.out[i] = v; }
    }
#endif
    if (hi == N_PHASES && blockIdx.x == 0 && F.tid == 0) {
        if (__hip_atomic_load(ctl + CW_BAR + XB_TMO, RLX_AGENT) != 0u) F.out[0] = __builtin_nanf("");
    }
#undef PH
#undef SEAM
}

extern "C" void kernel_launch(void* const* d_in, const int* in_sizes, int n_in, void* d_out, int out_size, void* d_ws, size_t ws_size, hipStream_t stream) {
    static int grid = 0;
    if (grid == 0) {
        if (n_in != N_IN || in_sizes[0] != RL * D || out_size != RL * D || ws_size < WS_END) { fprintf(stderr, "kernel_launch: unexpected shapes (n_in %d, in0 %d, out %d, ws %zu); nothing launched\n", n_in, n_in > 0 ? in_sizes[0] : -1, out_size, ws_size); grid = -1; return; }
        int dev = 0, cus = 0, per_cu = 0;
        if (hipGetDevice(&dev) != hipSuccess || hipDeviceGetAttribute(&cus, hipDeviceAttributeMultiprocessorCount, dev) != hipSuccess) { fprintf(stderr, "kernel_launch: device query failed\n"); grid = -1; return; }
        if (hipFuncSetAttribute((const void*)mk_fwd, hipFuncAttributeMaxDynamicSharedMemorySize, LDS_BYTES) != hipSuccess) { fprintf(stderr, "kernel_launch: hipFuncSetAttribute failed\n"); grid = -1; return; }
        if (hipOccupancyMaxActiveBlocksPerMultiprocessor(&per_cu, (const void*)mk_fwd, NWAVES * 64, LDS_BYTES) != hipSuccess || per_cu < 1) fprintf(stderr, "kernel_launch: note: occupancy query reports %d workgroups per CU\n", per_cu);
        (void)hipGetLastError();
        grid = cus;
    }
    if (grid < 0) return;
    if (hipMemsetAsync((char*)d_ws + WS_CTL, 0, CTL_ZERO_BYTES, stream) != hipSuccess) { fprintf(stderr, "kernel_launch: memset failed\n"); return; }
    Args a{};
    for (int i = 0; i < N_IN; ++i) a.in[i] = (const float*)d_in[i];
    a.out = (float*)d_out; a.ws = (unsigned char*)d_ws;
#if defined(DBG_DUMP)
    for (int p = 0; p < DBG_STOP; ++p) { a.ph_lo = p; a.ph_hi = p + 1; hipLaunchKernelGGL(mk_fwd, dim3(grid), dim3(NWAVES * 64), LDS_BYTES, stream, a); }
    a.ph_lo = N_PHASES; a.ph_hi = N_PHASES + 1; hipLaunchKernelGGL(mk_fwd, dim3(grid), dim3(NWAVES * 64), LDS_BYTES, stream, a);
#elif MK_PER_PHASE
    for (int p = 0; p < N_PHASES; ++p) { a.ph_lo = p; a.ph_hi = p + 1; hipLaunchKernelGGL(mk_fwd, dim3(grid), dim3(NWAVES * 64), LDS_BYTES, stream, a); }
#else
    a.ph_lo = 0; a.ph_hi = N_PHASES;
    hipLaunchKernelGGL(mk_fwd, dim3(grid), dim3(NWAVES * 64), LDS_BYTES, stream, a);
#endif
    const hipError_t le = hipPeekAtLastError();
    if (le != hipSuccess) fprintf(stderr, "kernel_launch: launch failed: %s\n", hipGetErrorName(le));
}
```
